# Optimizing an MI355X kernel written in HIP

```python
import functools
import jax, jax.numpy as jnp
from jax import lax
import numpy as np

D_MODEL = 1024
BATCH = 32
SEQ = 2048
DEPTH = 1
DEC_BATCH = 32
DEC_SEQ = 64
PAST_LEN = 4096

CHUNK = 64
N_HEADS = 8
HEAD_DIM = 64
ATT_DIM = N_HEADS * HEAD_DIM
BAND_CHUNKS = 8
BAND_PAST = BAND_CHUNKS * CHUNK
MAX_REL = 128
CONV_DIM = 512
CONV_W = 3
D_FF = -(-8 * D_MODEL // (3 * 256)) * 256
IN_DIM = 3 * CONV_DIM + 3 * ATT_DIM + 2 * D_MODEL
RMS_EPS = 1e-6
NEG_INF = -1e30

kernel_name = "chunk_stream_gated_conv_band_attn_hybrid"


def rmsnorm(x, g):
    xf = x.astype(jnp.float32)
    y = xf * lax.rsqrt(jnp.mean(xf * xf, axis=-1, keepdims=True) + RMS_EPS)
    return y.astype(x.dtype) * g


def causal_conv(u, prefix, w):
    L = u.shape[1]
    up = jnp.concatenate([prefix, u], axis=1)
    y = w[0] * up[:, 0:L]
    for j in range(1, CONV_W):
        y = y + w[j] * up[:, j:j + L]
    return y, up[:, -(CONV_W - 1):]


def band_attend(q, k, v, q_pos, k_pos, rel_bias):
    s = jnp.einsum('bqhd,bkhd->bhqk', q.astype(jnp.float32), k.astype(jnp.float32)) * (HEAD_DIM ** -0.5)
    rel = q_pos[:, None] - k_pos[None, :]
    bias = rel_bias[:, jnp.clip(rel, -MAX_REL, MAX_REL) + MAX_REL].astype(jnp.float32)
    qc = q_pos // CHUNK
    kc = k_pos // CHUNK
    allowed = ((k_pos[None, :] >= 0) & (kc[None, :] <= qc[:, None])
               & (kc[None, :] >= qc[:, None] - BAND_CHUNKS))
    s = jnp.where(allowed[None, None], s + bias[None], NEG_INF)
    p = jax.nn.softmax(s, axis=-1)
    return jnp.einsum('bhqk,bkhd->bqhd', p, v.astype(jnp.float32)).astype(v.dtype)


def prompt_band_attention(q, k, v, rel_bias):
    B, L, H, Dh = q.shape
    nc = L // CHUNK
    pad = jnp.zeros((B, BAND_PAST, H, Dh), k.dtype)
    kp = jnp.concatenate([pad, k], axis=1)
    vp = jnp.concatenate([pad, v], axis=1)
    qcs = q.reshape(B, nc, CHUNK, H, Dh).transpose(1, 0, 2, 3, 4)

    def one_chunk(args):
        c, qb = args
        start = c * CHUNK
        kb = lax.dynamic_slice_in_dim(kp, start, BAND_PAST + CHUNK, axis=1)
        vb = lax.dynamic_slice_in_dim(vp, start, BAND_PAST + CHUNK, axis=1)
        q_pos = start + jnp.arange(CHUNK)
        k_pos = start - BAND_PAST + jnp.arange(BAND_PAST + CHUNK)
        return band_attend(qb, kb, vb, q_pos, k_pos, rel_bias)

    out = lax.map(one_chunk, (jnp.arange(nc), qcs))
    return out.transpose(1, 0, 2, 3, 4).reshape(B, L, H, Dh)


def prompt_attn(l, q, k, v, rel_bias):
    out = prompt_band_attention(q, k, v, rel_bias[l])
    rows = min(BAND_PAST, q.shape[1])
    return out, k[:, -rows:], v[:, -rows:]


def sample_attn(l, q, k, v, rel_bias, cache_k, cache_v):
    rows = cache_k.shape[2]
    Lq = q.shape[1]
    k_all = jnp.concatenate([cache_k[l], k], axis=1)
    v_all = jnp.concatenate([cache_v[l], v], axis=1)
    q_pos = PAST_LEN + jnp.arange(Lq)
    k_pos = PAST_LEN - rows + jnp.arange(rows + Lq)
    out = band_attend(q, k_all, v_all, q_pos, k_pos, rel_bias[l])
    return out, k_all[:, -rows:], v_all[:, -rows:]


def mixer(xn, conv_prefix, attn_fn, w_in, w_conv, w_conv_out, w_attn_out, w_out):
    B, L, _ = xn.shape
    proj = xn @ w_in
    splits = [CONV_DIM, 2 * CONV_DIM, 3 * CONV_DIM,
              3 * CONV_DIM + ATT_DIM, 3 * CONV_DIM + 2 * ATT_DIM, 3 * CONV_DIM + 3 * ATT_DIM,
              3 * CONV_DIM + 3 * ATT_DIM + D_MODEL]
    cb, cc, ch, q, k, v, ga, gb = jnp.split(proj, splits, axis=-1)
    cv, conv_state = causal_conv(cc * ch, conv_prefix, w_conv)
    ya = (cb * cv) @ w_conv_out
    heads = lambda t: t.reshape(B, L, N_HEADS, HEAD_DIM)
    o, new_k, new_v = attn_fn(heads(q), heads(k), heads(v))
    yb = o.reshape(B, L, ATT_DIM) @ w_attn_out
    merged = jax.nn.sigmoid(ga) * ya + jax.nn.sigmoid(gb) * yb
    return merged @ w_out, conv_state, new_k, new_v


def swiglu(x, w1, w3, w2):
    return (jax.nn.silu(x @ w1) * (x @ w3)) @ w2


def trunk(x, conv_prefix, attn_fn, g_mix, w_in, w_conv, w_conv_out, w_attn_out, w_out,
          g_ffn, w_ff1, w_ff3, w_ff2, g_final):
    convs, ks, vs = [], [], []
    for l in range(DEPTH):
        m, cs, nk, nv = mixer(rmsnorm(x, g_mix[l]), conv_prefix[l], functools.partial(attn_fn, l),
                              w_in[l], w_conv[l], w_conv_out[l], w_attn_out[l], w_out[l])
        x = x + m
        x = x + swiglu(rmsnorm(x, g_ffn[l]), w_ff1[l], w_ff3[l], w_ff2[l])
        convs.append(cs)
        ks.append(nk)
        vs.append(nv)
    return rmsnorm(x, g_final), jnp.stack(convs), jnp.stack(ks), jnp.stack(vs)


def setup_inputs(seed: int = 0) -> dict:
    key = jax.random.key(seed)
    ks = jax.random.split(key, 20)
    kv_rows = min(BAND_PAST, PAST_LEN)
    n = jax.random.normal
    f32 = jnp.float32
    return {
        "x_prompt": n(ks[0], (BATCH, SEQ, D_MODEL), f32),
        "x_sample": n(ks[1], (DEC_BATCH, DEC_SEQ, D_MODEL), f32),
        "state_conv": n(ks[2], (DEPTH, DEC_BATCH, CONV_W - 1, CONV_DIM), f32),
        "cache_k": n(ks[3], (DEPTH, DEC_BATCH, kv_rows, N_HEADS, HEAD_DIM), f32),
        "cache_v": n(ks[4], (DEPTH, DEC_BATCH, kv_rows, N_HEADS, HEAD_DIM), f32),
        "g_mix": 1.0 + 0.1 * n(ks[5], (DEPTH, D_MODEL), f32),
        "w_in": n(ks[6], (DEPTH, D_MODEL, IN_DIM), f32) * D_MODEL ** -0.5,
        "w_conv": n(ks[7], (DEPTH, CONV_W, CONV_DIM), f32) * CONV_W ** -0.5,
        "w_conv_out": n(ks[8], (DEPTH, CONV_DIM, D_MODEL), f32) * CONV_DIM ** -0.5,
        "rel_bias": 0.5 * n(ks[9], (DEPTH, N_HEADS, 2 * MAX_REL + 1), f32),
        "w_attn_out": n(ks[10], (DEPTH, ATT_DIM, D_MODEL), f32) * ATT_DIM ** -0.5,
        "w_out": n(ks[11], (DEPTH, D_MODEL, D_MODEL), f32) * D_MODEL ** -0.5,
        "g_ffn": 1.0 + 0.1 * n(ks[12], (DEPTH, D_MODEL), f32),
        "w_ff1": n(ks[13], (DEPTH, D_MODEL, D_FF), f32) * D_MODEL ** -0.5,
        "w_ff3": n(ks[14], (DEPTH, D_MODEL, D_FF), f32) * D_MODEL ** -0.5,
        "w_ff2": n(ks[15], (DEPTH, D_FF, D_MODEL), f32) * D_FF ** -0.5,
        "g_final": 1.0 + 0.1 * n(ks[16], (D_MODEL,), f32),
    }


def reference(x_prompt, x_sample, state_conv, cache_k, cache_v, g_mix, w_in, w_conv, w_conv_out,
              rel_bias, w_attn_out, w_out, g_ffn, w_ff1, w_ff3, w_ff2, g_final):
    zero_prefix = jnp.zeros((DEPTH, x_prompt.shape[0], CONV_W - 1, CONV_DIM), x_prompt.dtype)
    y_prompt, conv_p, k_p, v_p = trunk(
        x_prompt, zero_prefix, functools.partial(prompt_attn, rel_bias=rel_bias),
        g_mix, w_in, w_conv, w_conv_out, w_attn_out, w_out, g_ffn, w_ff1, w_ff3, w_ff2, g_final)
    y_sample, conv_s, k_s, v_s = trunk(
        x_sample, state_conv,
        functools.partial(sample_attn, rel_bias=rel_bias, cache_k=cache_k, cache_v=cache_v),
        g_mix, w_in, w_conv, w_conv_out, w_attn_out, w_out, g_ffn, w_ff1, w_ff3, w_ff2, g_final)
    return (y_prompt, y_sample, conv_p, k_p, v_p, conv_s, k_s, v_s)
```

```cpp
#include <hip/hip_runtime.h>
#include <hip/hip_cooperative_groups.h>
#include <cstdio>
#include <cstdint>
namespace cg = cooperative_groups;

#define LAS __attribute__((address_space(3)))
typedef unsigned short bf16_t;
typedef short bf16x8 __attribute__((ext_vector_type(8)));
typedef short s16x4 __attribute__((ext_vector_type(4)));
typedef float f32x4 __attribute__((ext_vector_type(4)));
typedef float f32x16 __attribute__((ext_vector_type(16)));
typedef unsigned u32x4 __attribute__((ext_vector_type(4)));
typedef unsigned u32x2 __attribute__((ext_vector_type(2)));

constexpr int D = 1024, NB = 32, SEQ = 2048, DSEQ = 64, MP = NB * SEQ, MS = NB * DSEQ, M = MP + MS;
constexpr int CD = 512, AD = 512, NH = 8, HD = 64, DFF = 2816, NIN = 5120, NFF = 2 * DFF, KVR = 512, KSR = KVR + DSEQ;
constexpr float EPS = 1e-6f;
constexpr float LOG2E = 1.4426950408889634f;
constexpr float C2 = 0.125f * LOG2E;
constexpr size_t OFF_Y = 0, OFF_CONVP = (size_t)M * D, OFF_KP = OFF_CONVP + (size_t)NB * 2 * CD, OFF_VP = OFF_KP + (size_t)NB * KVR * AD,
                 OFF_CONVS = OFF_VP + (size_t)NB * KVR * AD, OFF_KS = OFF_CONVS + (size_t)NB * 2 * CD, OFF_VS = OFF_KS + (size_t)NB * KVR * AD;
constexpr size_t MiB = 1u << 20;
constexpr size_t WS_CTL = 0, CTL_BYTES = 1 * MiB;
constexpr size_t CTL_SS1 = 4096, CTL_SS2 = CTL_SS1 + (size_t)M * 4;
static_assert(CTL_SS2 + (size_t)M * 4 <= CTL_BYTES, "ctl");
constexpr size_t WS_WIN = 2 * MiB, WS_WCO = 12 * MiB, WS_WAO = 13 * MiB, WS_WOUT = 14 * MiB, WS_W13 = 16 * MiB, WS_W2 = 27 * MiB;
constexpr size_t WS_R2 = 34 * MiB, WS_R1 = 166 * MiB;
constexpr size_t WS_CB = 298 * MiB, WS_U = 364 * MiB, WS_Q = 430 * MiB, WS_KB = 496 * MiB, WS_VB = 562 * MiB;
constexpr size_t WS_SGA = 628 * MiB, WS_SGB = 760 * MiB;
constexpr size_t WS_KS = 892 * MiB, WS_VS = 910 * MiB;
constexpr size_t WS_H = 166 * MiB;
constexpr size_t WS_X1 = 628 * MiB;
constexpr size_t WS_END = 928 * MiB;
static_assert(WS_H + (size_t)M * DFF * 2 <= WS_X1 && WS_X1 + (size_t)M * D * 4 <= WS_KS, "ws map");

constexpr int RING_BYTES = 131072, TBL_OFF = RING_BYTES, TBL_STRIDE = 320, MISC_OFF = TBL_OFF + NH * TBL_STRIDE * 4, LDS_BYTES = 147456;
static_assert(MISC_OFF + 256 <= LDS_BYTES, "lds");

namespace pg8 {
constexpr int BM = 256, BK = 64, HALF = 128, HTB = HALF * BK * 2, NXCD = 8, WGM = 8;
__host__ __device__ __forceinline__ int lds_byte(int r, int c) { const int st = (r >> 4) * 2 + (c >> 5), rr = r & 15, cc = c & 31, ob = rr * 64 + cc * 2; return st * 1024 + (ob ^ (((ob >> 9) & 1) << 5)); }
__host__ __device__ __forceinline__ void stage_rc(int b, int& R, int& C) { const int st = b / 1024, sb = b % 1024, swz = sb ^ (((sb >> 9) & 1) << 5); R = (st >> 1) * 16 + swz / 64; C = (st & 1) * 32 + (swz % 64) / 2; }
__host__ __device__ __forceinline__ int perm32(int rho) { const int n = rho >> 4, i = rho & 15; return 8 * (i >> 2) + 4 * n + (i & 3); }

struct Unit { int pm, pn; };
struct Gemm { const bf16_t* A; const bf16_t* Bt; int M, N, K, lda, ldb; };

struct StaticOrder {
    int nM, nN, nwg, G, c;
    __host__ __device__ void init(int M_, int N_, int G_, int c_) { nM = M_ / BM; nN = N_ / BM; nwg = nM * nN; G = G_; c = c_; }
    __host__ __device__ bool next(int i, Unit& u) const {
        const long L = (long)i * G + c; if (L >= nwg) return false;
        int wgid = (int)L; { const int q = nwg / NXCD, r = nwg % NXCD, xcd = wgid % NXCD, off = wgid / NXCD; wgid = (xcd < r ? xcd * (q + 1) : r * (q + 1) + (xcd - r) * q) + off; }
        const int nig = WGM * nN, gid = wgid / nig, fm = gid * WGM, gsz = (nM - fm) < WGM ? (nM - fm) : WGM;
        u.pm = fm + ((wgid % nig) % gsz); u.pn = (wgid % nig) / gsz; return true;
    }
};

typedef float f32x2_t __attribute__((ext_vector_type(2))); typedef __bf16 bf16x2_t __attribute__((ext_vector_type(2)));
__device__ __forceinline__ unsigned cvt_pk_bf16(float lo, float hi) { f32x2_t v = {lo, hi}; bf16x2_t b = __builtin_convertvector(v, bf16x2_t); return __builtin_bit_cast(unsigned, b); }
__device__ __forceinline__ u32x4 pack8(f32x4 v0, f32x4 v1) { u32x4 w; w.x = cvt_pk_bf16(v0[0], v0[1]); w.y = cvt_pk_bf16(v0[2], v0[3]); w.z = cvt_pk_bf16(v1[0], v1[1]); w.w = cvt_pk_bf16(v1[2], v1[3]); return w; }
__device__ __forceinline__ void unpack8(u32x4 w, f32x4& v0, f32x4& v1) {
    v0[0] = __uint_as_float(w.x << 16); v0[1] = __uint_as_float(w.x & 0xffff0000u); v0[2] = __uint_as_float(w.y << 16); v0[3] = __uint_as_float(w.y & 0xffff0000u);
    v1[0] = __uint_as_float(w.z << 16); v1[1] = __uint_as_float(w.z & 0xffff0000u); v1[2] = __uint_as_float(w.w << 16); v1[3] = __uint_as_float(w.w & 0xffff0000u);
}

template <class Epi>
__device__ __forceinline__ void gemm_phase(LAS unsigned char* lds, const Gemm g, const StaticOrder& S, const Epi& E) {
    int tid_ = threadIdx.x; asm volatile("" : "+v"(tid_));
    const int tid = tid_, wid = __builtin_amdgcn_readfirstlane(tid >> 6), lane = tid & 63, wr = wid >> 2, wc = wid & 3, fr = lane & 15, fq = lane >> 4;
    const int K = g.K, nt = K / BK;
    unsigned voffA[2], voffB[2];
#pragma unroll
    for (int i = 0; i < 2; ++i) { int R, C; stage_rc(tid * 16 + i * 8192, R, C); const int Rb = (R & ~31) + perm32(R & 31);
        voffA[i] = (unsigned)(R * g.lda + C) * 2u; voffB[i] = (unsigned)(Rb * g.ldb + C) * 2u; }
    const size_t kstep = (size_t)(BK * 2);
    const size_t hstepA = (size_t)HALF * g.lda * 2, hstepB = (size_t)HALF * g.ldb * 2;
    const size_t tstepA = 2 * hstepA, tstepB = 2 * hstepB;
    const unsigned ldsw = (unsigned)wid * 1024u;
    const int aoff = lds_byte(wr * 64 + fr, fq * 8), boff = lds_byte(wc * 32 + fr, fq * 8);
#define PG8_SA(b, h) (((b) * 2 + (h)) * HTB)
#define PG8_SB(b, h) ((4 + (b) * 2 + (h)) * HTB)
#define PG8_STAGE(bufoff, gbase, voff) do { _Pragma("unroll") for (int _i = 0; _i < 2; ++_i) \
        __builtin_amdgcn_global_load_lds((const unsigned*)((const char*)(gbase) + (voff)[_i]), (LAS unsigned*)(lds + (bufoff) + ldsw + _i * 8192), 16, 0, 0); } while (0)
#define PG8_LDA(dst, b, h) do { _Pragma("unroll") for (int m = 0; m < 4; ++m) _Pragma("unroll") for (int k = 0; k < 2; ++k) dst[m][k] = *(const LAS bf16x8*)(lds + PG8_SA(b, h) + aoff + m * 2048 + k * 1024); } while (0)
#define PG8_LDB(dst, b, h) do { _Pragma("unroll") for (int n = 0; n < 2; ++n) _Pragma("unroll") for (int k = 0; k < 2; ++k) dst[n][k] = *(const LAS bf16x8*)(lds + PG8_SB(b, h) + boff + n * 2048 + k * 1024); } while (0)
#define PG8_MMA(ai, bj, At, Bt) do { __builtin_amdgcn_s_setprio(1); _Pragma("unroll") for (int m = 0; m < 4; ++m) _Pragma("unroll") for (int n = 0; n < 2; ++n) _Pragma("unroll") for (int k = 0; k < 2; ++k) \
        acc[ai][bj][m][n] = __builtin_amdgcn_mfma_f32_16x16x32_bf16(Bt[n][k], At[m][k], acc[ai][bj][m][n], 0, 0, 0); __builtin_amdgcn_s_setprio(0); } while (0)
#define PG8_WAIT_V(n) asm volatile("s_waitcnt vmcnt(" #n ")" ::: "memory")
#define PG8_WAIT_L(n) asm volatile("s_waitcnt lgkmcnt(" #n ")" ::: "memory")
#define PG8_BAR __builtin_amdgcn_s_barrier()
#define PG8_SCHED __builtin_amdgcn_sched_barrier(0)
    Unit cur, nxt; int ui = 0;
    if (!S.next(0, cur)) return;
    f32x4 acc[2][2][4][2];
#pragma unroll
    for (int a = 0; a < 2; ++a)
#pragma unroll
        for (int b = 0; b < 2; ++b)
#pragma unroll
            for (int m = 0; m < 4; ++m)
#pragma unroll
                for (int n = 0; n < 2; ++n) acc[a][b][m][n] = (f32x4){0.f, 0.f, 0.f, 0.f};
    bf16x8 At[4][2], B0[2][2], B1[2][2];
    const char* cA = (const char*)g.A + (size_t)cur.pm * tstepA; const char* cB = (const char*)g.Bt + (size_t)cur.pn * tstepB;
    PG8_STAGE(PG8_SB(0, 0), cB, voffB); PG8_STAGE(PG8_SB(0, 1), cB + hstepB, voffB); PG8_STAGE(PG8_SA(0, 0), cA, voffA); PG8_STAGE(PG8_SA(0, 1), cA + hstepA, voffA);
    if (wr == 1) PG8_BAR;
    PG8_WAIT_V(2); PG8_BAR;
    PG8_STAGE(PG8_SB(1, 0), cB + kstep, voffB); PG8_STAGE(PG8_SA(1, 0), cA + kstep, voffA); PG8_STAGE(PG8_SB(1, 1), cB + hstepB + kstep, voffB);
    PG8_WAIT_V(6); PG8_BAR;
    for (;;) {
        const bool has_next = S.next(ui + 1, nxt);
        const char* nA = has_next ? (const char*)g.A + (size_t)nxt.pm * tstepA : cA; const char* nB = has_next ? (const char*)g.Bt + (size_t)nxt.pn * tstepB : cB;
        for (int t = 0; t < nt; t += 2) {
            const bool last = (t == nt - 2);
            const char* a1 = cA + (size_t)(t + 1) * kstep;
            const char* a2 = last ? nA : cA + (size_t)(t + 2) * kstep; const char* b2 = last ? nB : cB + (size_t)(t + 2) * kstep;
            const char* a3 = a2 + kstep; const char* b3 = b2 + kstep;
            PG8_LDB(B0, 0, 0); PG8_LDB(B1, 0, 1); PG8_SCHED; PG8_LDA(At, 0, 0); PG8_STAGE(PG8_SA(1, 1), a1 + hstepA, voffA);
            PG8_WAIT_V(8); PG8_WAIT_L(0); PG8_BAR; PG8_MMA(0, 0, At, B0); PG8_MMA(0, 1, At, B1); PG8_BAR; PG8_SCHED;
            PG8_LDA(At, 0, 1); PG8_STAGE(PG8_SB(0, 0), b2, voffB); PG8_STAGE(PG8_SB(0, 1), b2 + hstepB, voffB); PG8_STAGE(PG8_SA(0, 0), a2, voffA);
            PG8_WAIT_V(8); PG8_WAIT_L(0); PG8_BAR; PG8_MMA(1, 0, At, B0); PG8_MMA(1, 1, At, B1); PG8_BAR; PG8_SCHED;
            PG8_LDB(B0, 1, 0); PG8_LDB(B1, 1, 1); PG8_SCHED; PG8_LDA(At, 1, 0); PG8_STAGE(PG8_SA(0, 1), a2 + hstepA, voffA);
            PG8_WAIT_V(8); PG8_WAIT_L(0); PG8_BAR; PG8_MMA(0, 0, At, B0); PG8_MMA(0, 1, At, B1); PG8_BAR; PG8_SCHED;
            PG8_LDA(At, 1, 1); PG8_STAGE(PG8_SB(1, 0), b3, voffB); PG8_STAGE(PG8_SB(1, 1), b3 + hstepB, voffB); PG8_STAGE(PG8_SA(1, 0), a3, voffA);
            PG8_WAIT_V(8); PG8_WAIT_L(0); PG8_BAR; PG8_MMA(1, 0, At, B0); PG8_MMA(1, 1, At, B1); PG8_BAR; PG8_SCHED;
        }
        if (wr == 0) PG8_BAR;
        E(acc, cur, wr, wc, fr, fq);
        if (!has_next) break;
#pragma unroll
        for (int a = 0; a < 2; ++a)
#pragma unroll
            for (int b = 0; b < 2; ++b)
#pragma unroll
                for (int m = 0; m < 4; ++m)
#pragma unroll
                    for (int n = 0; n < 2; ++n) acc[a][b][m][n] = (f32x4){0.f, 0.f, 0.f, 0.f};
        cur = nxt; cA = nA; cB = nB; ++ui;
        if (wr == 1) PG8_BAR;
    }
    PG8_WAIT_V(0);
    PG8_BAR;
#undef PG8_SA
#undef PG8_SB
#undef PG8_STAGE
#undef PG8_LDA
#undef PG8_LDB
#undef PG8_MMA
#undef PG8_WAIT_V
#undef PG8_WAIT_L
#undef PG8_BAR
#undef PG8_SCHED
}
}
using pg8::Unit; using pg8::pack8; using pg8::unpack8;

#define EPI_FENCE() asm volatile("" ::: "memory")
__device__ __forceinline__ float sigmoidf_(float x) { return __builtin_amdgcn_rcpf(1.0f + __builtin_amdgcn_exp2f(-x * LOG2E)); }

#define LAUNDER_V(x) asm volatile("" : "+v"(x))
#define ST16(base, off, v) (*(u32x4*)((char*)(base) + (off)) = (v))
#define ST16F(base, off, v) (*(f32x4*)((char*)(base) + (off)) = (v))
#define LD16(base, off) (*(const u32x4*)((const char*)(base) + (off)))
#define LD16F(base, off) (*(const f32x4*)((const char*)(base) + (off)))
struct EpiInProj {
    unsigned char* ws; float* out;
    __device__ __forceinline__ void operator()(const f32x4 (&acc)[2][2][4][2], const Unit& u, int wr, int wc, int fr, int fq) const {
        const int pn = u.pn, pm = u.pm;
        const bool sample = pm >= MP / 256;
        unsigned lr0 = wr * 64 + fr, col8 = wc * 32 + 8 * fq;
        if (pn >= 2 && pn < 6) {
            LAUNDER_V(lr0); LAUNDER_V(col8);
            unsigned char* U = ws + WS_U + ((size_t)pm * 256 * CD + 128 * (pn - 2)) * 2;
            const unsigned vo = (lr0 * CD + col8) * 2;
#pragma unroll
            for (int ai = 0; ai < 2; ++ai) {
#pragma unroll
                for (int m = 0; m < 4; ++m) {
                    const f32x4 a0 = acc[ai][0][m][0] * acc[ai][1][m][0], a1 = acc[ai][0][m][1] * acc[ai][1][m][1];
                    ST16(U, vo + (ai * 128 + m * 16) * CD * 2, pack8(a0, a1));
                    if (m == 3) {
                        const int lr = (int)lr0 + ai * 128 + 48; float* d = nullptr; const int ch0 = 128 * (pn - 2) + (int)col8;
                        if (!sample) { if ((pm & 7) == 7 && lr >= 254) d = out + OFF_CONVP + ((size_t)((pm >> 3) * 2 + (lr - 254)) * CD + ch0); }
                        else { const int t = lr & 63, b = (pm - MP / 256) * 4 + (lr >> 6); if (t >= DSEQ - 2) d = out + OFF_CONVS + ((size_t)(b * 2 + (t - (DSEQ - 2))) * CD + ch0); }
                        if (d) { *(f32x4*)d = a0; *(f32x4*)(d + 4) = a1; }
                    }
                }
                EPI_FENCE();
            }
        } else if (pn < 8) {
            LAUNDER_V(lr0); LAUNDER_V(col8);
            unsigned char* dst = ws + (pn < 2 ? WS_CB : WS_Q) + ((size_t)pm * 256 * 512 + 256 * (pn & 1)) * 2; const float sc = pn < 2 ? 1.0f : C2;
            const unsigned vo = (lr0 * 512 + col8) * 2;
#pragma unroll
            for (int ai = 0; ai < 2; ++ai) {
#pragma unroll
                for (int m = 0; m < 4; ++m)
#pragma unroll
                    for (int bj = 0; bj < 2; ++bj) ST16(dst, vo + ((ai * 128 + m * 16) * 512 + bj * 128) * 2, pack8(acc[ai][bj][m][0] * sc, acc[ai][bj][m][1] * sc));
                EPI_FENCE();
            }
        } else if (pn < 12) {
            LAUNDER_V(lr0); LAUNDER_V(col8);
            const bool isV = pn >= 10; const int cb0 = 256 * (pn & 1);
            if (!sample) {
                unsigned char* db = ws + (isV ? WS_VB : WS_KB) + ((size_t)pm * 256 * 512 + cb0) * 2;
                const unsigned vo = (lr0 * 512 + col8) * 2;
#pragma unroll
                for (int ai = 0; ai < 2; ++ai) {
#pragma unroll
                    for (int m = 0; m < 4; ++m)
#pragma unroll
                        for (int bj = 0; bj < 2; ++bj) ST16(db, vo + ((ai * 128 + m * 16) * 512 + bj * 128) * 2, pack8(acc[ai][bj][m][0], acc[ai][bj][m][1]));
                    EPI_FENCE();
                }
                if ((pm & 7) >= 6) {
                    float* df = out + (isV ? OFF_VP : OFF_KP) + (size_t)((pm >> 3) * KVR + ((pm & 7) - 6) * 256) * 512 + cb0;
                    const unsigned vf = (lr0 * 512 + col8) * 4;
#pragma unroll
                    for (int ai = 0; ai < 2; ++ai) {
#pragma unroll
                        for (int m = 0; m < 4; ++m)
#pragma unroll
                            for (int bj = 0; bj < 2; ++bj) { const unsigned o = vf + ((ai * 128 + m * 16) * 512 + bj * 128) * 4; ST16F(df, o, acc[ai][bj][m][0]); ST16F(df, o + 16, acc[ai][bj][m][1]); }
                        EPI_FENCE();
                    }
                }
            } else {
                const unsigned t0 = lr0 & 63, bq = lr0 >> 6;
                const unsigned vo = (t0 * 512 + col8) * 2, vf = (t0 * 512 + col8) * 4;
#pragma unroll
                for (int ai = 0; ai < 2; ++ai) {
                    const int b = (pm - MP / 256) * 4 + __builtin_amdgcn_readfirstlane(bq) + 2 * ai;
                    unsigned char* db = ws + (isV ? WS_VS : WS_KS) + ((size_t)(b * KSR + KVR) * 512 + cb0) * 2;
                    float* df = out + (isV ? OFF_VS : OFF_KS) + (size_t)(b * KVR + (KVR - DSEQ)) * 512 + cb0;
#pragma unroll
                    for (int m = 0; m < 4; ++m)
#pragma unroll
                        for (int bj = 0; bj < 2; ++bj) { ST16(db, vo + (m * 16 * 512 + bj * 128) * 2, pack8(acc[ai][bj][m][0], acc[ai][bj][m][1]));
                            const unsigned o = vf + (m * 16 * 512 + bj * 128) * 4; ST16F(df, o, acc[ai][bj][m][0]); ST16F(df, o + 16, acc[ai][bj][m][1]); }
                    EPI_FENCE();
                }
            }
        } else {
            LAUNDER_V(lr0); LAUNDER_V(col8);
            unsigned char* dst = ws + (pn >= 16 ? WS_SGB : WS_SGA) + ((size_t)pm * 256 * D + 256 * (pn & 3)) * 2;
            const unsigned vo = (lr0 * D + col8) * 2;
#pragma unroll
            for (int ai = 0; ai < 2; ++ai) {
#pragma unroll
                for (int m = 0; m < 4; ++m)
#pragma unroll
                    for (int bj = 0; bj < 2; ++bj) { f32x4 v0 = acc[ai][bj][m][0], v1 = acc[ai][bj][m][1];
#pragma unroll
                        for (int e = 0; e < 4; ++e) { v0[e] = sigmoidf_(v0[e]); v1[e] = sigmoidf_(v1[e]); }
                        ST16(dst, vo + ((ai * 128 + m * 16) * D + bj * 128) * 2, pack8(v0, v1)); }
                EPI_FENCE();
            }
        }
    }
};

template <bool SECOND> struct EpiGate {
    unsigned char* ws;
    __device__ __forceinline__ void operator()(const f32x4 (&acc)[2][2][4][2], const Unit& u, int wr, int wc, int fr, int fq) const {
        const size_t tb = ((size_t)u.pm * 256 * D + u.pn * 256) * 2;
        const unsigned char* G = ws + (SECOND ? WS_SGB : WS_SGA) + tb; unsigned char* T = ws + WS_R1 + tb;
        unsigned lr0 = wr * 64 + fr, col8 = wc * 32 + 8 * fq; LAUNDER_V(lr0); LAUNDER_V(col8);
        const unsigned vo = (lr0 * D + col8) * 2;
#pragma unroll
        for (int ai = 0; ai < 2; ++ai)
#pragma unroll
            for (int m = 0; m < 4; ++m) {
                u32x4 gw[2], tw[2];
#pragma unroll
                for (int bj = 0; bj < 2; ++bj) { const unsigned o = vo + ((ai * 128 + m * 16) * D + bj * 128) * 2; gw[bj] = LD16(G, o); if (SECOND) tw[bj] = LD16(T, o); }
#pragma unroll
                for (int bj = 0; bj < 2; ++bj) { const unsigned o = vo + ((ai * 128 + m * 16) * D + bj * 128) * 2;
                    f32x4 g0, g1; unpack8(gw[bj], g0, g1); f32x4 v0 = acc[ai][bj][m][0] * g0, v1 = acc[ai][bj][m][1] * g1;
                    if (SECOND) { f32x4 t0, t1; unpack8(tw[bj], t0, t1); v0 += t0; v1 += t1; }
                    ST16(T, o, pack8(v0, v1)); }
                if (m & 1) EPI_FENCE(); }
    }
};

template <bool FIRST> struct EpiResid {
    const float* xp; const float* xs;
    unsigned char* ws; float* out;
    __device__ __forceinline__ void operator()(const f32x4 (&acc)[2][2][4][2], const Unit& u, int wr, int wc, int fr, int fq) const {
        const size_t grow0 = (size_t)u.pm * 256; const int cb = u.pn * 256;
        const float* src; float* of; float* ss;
        if (FIRST) { src = ((u.pm >= MP / 256) ? xs + (grow0 - MP) * D : xp + grow0 * D) + cb; of = (float*)(ws + WS_X1) + grow0 * D + cb; ss = (float*)(ws + CTL_SS1) + grow0; }
        else { src = (const float*)(ws + WS_X1) + grow0 * D + cb; of = out + OFF_Y + grow0 * D + cb; ss = (float*)(ws + CTL_SS2) + grow0; }
        unsigned char* ob = ws + WS_R2 + (grow0 * D + cb) * 2;
        unsigned lr0 = wr * 64 + fr, col8 = wc * 32 + 8 * fq; LAUNDER_V(lr0); LAUNDER_V(col8);
        const unsigned ve = lr0 * D + col8;
#pragma unroll
        for (int ai = 0; ai < 2; ++ai)
#pragma unroll
            for (int m = 0; m < 4; ++m) {
                f32x4 r[2][2];
#pragma unroll
                for (int bj = 0; bj < 2; ++bj) { const unsigned o = (ve + (ai * 128 + m * 16) * D + bj * 128) * 4; r[bj][0] = LD16F(src, o); r[bj][1] = LD16F(src, o + 16); }
                float s = 0.f;
#pragma unroll
                for (int bj = 0; bj < 2; ++bj) { const unsigned e = ve + (ai * 128 + m * 16) * D + bj * 128;
                    const f32x4 v0 = acc[ai][bj][m][0] + r[bj][0], v1 = acc[ai][bj][m][1] + r[bj][1];
                    ST16F(of, e * 4, v0); ST16F(of, e * 4 + 16, v1);
                    if (FIRST) ST16(ob, e * 2, pack8(v0, v1));
                    s += (v0[0] * v0[0] + v0[1] * v0[1]) + (v0[2] * v0[2] + v0[3] * v0[3]) + (v1[0] * v1[0] + v1[1] * v1[1]) + (v1[2] * v1[2] + v1[3] * v1[3]); }
                s += __shfl_xor(s, 16); s += __shfl_xor(s, 32);
                if (fq == 0) unsafeAtomicAdd(ss + lr0 + ai * 128 + m * 16, s);
                if (m & 1) EPI_FENCE(); }
    }
};

struct EpiSwiGLU {
    unsigned char* ws;
    __device__ __forceinline__ void operator()(const f32x4 (&acc)[2][2][4][2], const Unit& u, int wr, int wc, int fr, int fq) const {
        const size_t grow0 = (size_t)u.pm * 256;
        const float* ss = (const float*)(ws + CTL_SS1) + grow0; unsigned char* H = ws + WS_H + (grow0 * DFF + u.pn * 128) * 2;
        unsigned lr0 = wr * 64 + fr, col8 = wc * 32 + 8 * fq; LAUNDER_V(lr0); LAUNDER_V(col8);
        const unsigned vo = (lr0 * DFF + col8) * 2;
        float rs[2][4];
#pragma unroll
        for (int ai = 0; ai < 2; ++ai)
#pragma unroll
            for (int m = 0; m < 4; ++m) rs[ai][m] = __builtin_amdgcn_rsqf(ss[lr0 + ai * 128 + m * 16] * (1.0f / D) + EPS);
#pragma unroll
        for (int ai = 0; ai < 2; ++ai)
#pragma unroll
            for (int m = 0; m < 4; ++m) { const float r = rs[ai][m]; f32x4 h[2];
#pragma unroll
                for (int n = 0; n < 2; ++n)
#pragma unroll
                    for (int e = 0; e < 4; ++e) { const float gv = acc[ai][0][m][n][e] * r, uv = acc[ai][1][m][n][e] * r; h[n][e] = gv * sigmoidf_(gv) * uv; }
                ST16(H, vo + (ai * 128 + m * 16) * DFF * 2, pack8(h[0], h[1])); }
    }
};

__device__ __forceinline__ void glds16(const void* gsrc, unsigned lds_dst) { unsigned keep;
    asm volatile("s_mov_b32 %0, m0\n\ts_mov_b32 m0, %2\n\ts_nop 0\n\tglobal_load_lds_dwordx4 %1, off\n\ts_mov_b32 m0, %0" : "=&s"(keep) : "v"(gsrc), "s"(lds_dst) : "memory"); }
typedef short v4i16_t __attribute__((ext_vector_type(4)));
__device__ __forceinline__ s16x4 vtr(const LAS unsigned char* p) { return __builtin_bit_cast(s16x4, __builtin_amdgcn_ds_read_tr16_b64_v4i16((LAS v4i16_t*)p)); }
__device__ __forceinline__ float swapmax(float v) { auto rr = __builtin_amdgcn_permlane32_swap(__float_as_uint(v), __float_as_uint(v), false, false); return fmaxf(__uint_as_float(rr[0]), __uint_as_float(rr[1])); }
__device__ __forceinline__ float swapsum(float v) { auto rr = __builtin_amdgcn_permlane32_swap(__float_as_uint(v), __float_as_uint(v), false, false); return __uint_as_float(rr[0]) + __uint_as_float(rr[1]); }

__device__ __forceinline__ void attn_unit(LAS unsigned char* wl, unsigned lds0w, const LAS float* tb, const bf16_t* Qp, const bf16_t* Kp, const bf16_t* Vp, int ntiles, bf16_t* Op, int lane) {
    const int r32 = lane & 31, hi = lane >> 5;
    bf16x8 qf[2][4];
#pragma unroll
    for (int qb = 0; qb < 2; ++qb)
#pragma unroll
        for (int d0 = 0; d0 < 4; ++d0) qf[qb][d0] = *(const bf16x8*)(Qp + (size_t)(32 * qb + r32) * 512 + 16 * d0 + 8 * hi);
    f32x16 o[2][2];
#pragma unroll
    for (int a = 0; a < 2; ++a)
#pragma unroll
        for (int b = 0; b < 2; ++b)
#pragma unroll
            for (int r = 0; r < 16; ++r) o[a][b][r] = 0.f;
    float mrun[2] = {-1e30f, -1e30f}, lrun[2] = {0.f, 0.f};
    const int pos = lane & 7, lrow = lane >> 3, x4 = lane >> 4;
    const unsigned koff0 = lrow * 1024 + ((pos ^ x4) * 16), koff1 = lrow * 1024 + ((pos ^ x4 ^ 4) * 16), voff = lrow * 1024 + ((pos ^ ((x4 & 1) << 2)) * 16);
    const unsigned kdst = lds0w, vdst = lds0w + 8192;
#define DMA_K(t) do { const char* _s = (const char*)Kp + (size_t)(t) * 65536; _Pragma("unroll") for (int _i = 0; _i < 8; ++_i) glds16(_s + _i * 8192 + ((_i & 1) ? koff1 : koff0), (unsigned)__builtin_amdgcn_readfirstlane(kdst + _i * 1024)); } while (0)
#define DMA_V(t) do { const char* _s = (const char*)Vp + (size_t)(t) * 65536; _Pragma("unroll") for (int _i = 0; _i < 8; ++_i) glds16(_s + _i * 8192 + voff, (unsigned)__builtin_amdgcn_readfirstlane(vdst + _i * 1024)); } while (0)
    const int xk = (r32 >> 1) & 7;
    const LAS unsigned char* kb[4];
#pragma unroll
    for (int d0 = 0; d0 < 4; ++d0) kb[d0] = wl + r32 * 128 + (((2 * d0 + hi) ^ xk) * 16);
    const int vl = (4 * hi + ((lane & 15) >> 2)) * 128 + (2 * ((lane >> 4) & 1) + ((lane & 3) >> 1)) * 16 + 8 * (lane & 1);
    const LAS unsigned char* vb[2];
    vb[0] = wl + 8192 + vl + 64 * (0 ^ ((lane >> 3) & 1)); vb[1] = wl + 8192 + vl + 64 * (1 ^ ((lane >> 3) & 1));
    DMA_K(0); DMA_V(0);
    for (int t = 0; t < ntiles; ++t) {
        const int dc = ntiles - 1 - t; const bool more = (t + 1 < ntiles);
        f32x16 s[2][2];
        if (dc <= 2) {
            const LAS float* bp = tb + (128 + 64 * dc + r32 - 4 * hi - 59);
#pragma unroll
            for (int kvb = 0; kvb < 2; ++kvb)
#pragma unroll
                for (int qb = 0; qb < 2; ++qb)
#pragma unroll
                    for (int r = 0; r < 16; ++r) s[kvb][qb][r] = bp[59 + 32 * (qb - kvb) - ((r & 3) + 8 * (r >> 2))];
        } else {
            const float c = tb[256];
#pragma unroll
            for (int kvb = 0; kvb < 2; ++kvb)
#pragma unroll
                for (int qb = 0; qb < 2; ++qb)
#pragma unroll
                    for (int r = 0; r < 16; ++r) s[kvb][qb][r] = c;
        }
        asm volatile("s_waitcnt vmcnt(8)" ::: "memory");
#pragma unroll
        for (int kvb = 0; kvb < 2; ++kvb)
#pragma unroll
            for (int d0 = 0; d0 < 4; ++d0) { const bf16x8 kf = *(const LAS bf16x8*)(kb[d0] + kvb * 4096);
                s[kvb][0] = __builtin_amdgcn_mfma_f32_32x32x16_bf16(kf, qf[0][d0], s[kvb][0], 0, 0, 0);
                s[kvb][1] = __builtin_amdgcn_mfma_f32_32x32x16_bf16(kf, qf[1][d0], s[kvb][1], 0, 0, 0); }
        asm volatile("s_waitcnt lgkmcnt(0)" ::: "memory");
        if (more) DMA_K(t + 1);
        bf16x8 pf[2][4];
#pragma unroll
        for (int qb = 0; qb < 2; ++qb) {
            float mx = s[0][qb][0];
#pragma unroll
            for (int r = 1; r < 16; ++r) mx = fmaxf(mx, s[0][qb][r]);
#pragma unroll
            for (int r = 0; r < 16; ++r) mx = fmaxf(mx, s[1][qb][r]);
            mx = swapmax(mx);
            const float mn = fmaxf(mrun[qb], mx), alpha = __builtin_amdgcn_exp2f(mrun[qb] - mn); mrun[qb] = mn;
            float ls = 0.f;
#pragma unroll
            for (int kvb = 0; kvb < 2; ++kvb)
#pragma unroll
                for (int r = 0; r < 16; ++r) { const float p = __builtin_amdgcn_exp2f(s[kvb][qb][r] - mn); s[kvb][qb][r] = p; ls += p; }
            lrun[qb] = lrun[qb] * alpha + ls;
#pragma unroll
            for (int db = 0; db < 2; ++db)
#pragma unroll
                for (int r = 0; r < 16; ++r) o[db][qb][r] *= alpha;
#pragma unroll
            for (int si = 0; si < 4; ++si) { const int kvb = si >> 1, r0 = 8 * (si & 1); u32x4 w;
                w.x = pg8::cvt_pk_bf16(s[kvb][qb][r0 + 0], s[kvb][qb][r0 + 1]); w.y = pg8::cvt_pk_bf16(s[kvb][qb][r0 + 2], s[kvb][qb][r0 + 3]);
                w.z = pg8::cvt_pk_bf16(s[kvb][qb][r0 + 4], s[kvb][qb][r0 + 5]); w.w = pg8::cvt_pk_bf16(s[kvb][qb][r0 + 6], s[kvb][qb][r0 + 7]);
                pf[qb][si] = __builtin_bit_cast(bf16x8, w); }
        }
        if (more) asm volatile("s_waitcnt vmcnt(8)" ::: "memory"); else asm volatile("s_waitcnt vmcnt(0)" ::: "memory");
#pragma unroll
        for (int si = 0; si < 4; ++si)
#pragma unroll
            for (int db = 0; db < 2; ++db) { const s16x4 lo = vtr(vb[db] + si * 2048), h4 = vtr(vb[db] + si * 2048 + 1024);
                const bf16x8 vf = (bf16x8){lo[0], lo[1], lo[2], lo[3], h4[0], h4[1], h4[2], h4[3]};
                o[db][0] = __builtin_amdgcn_mfma_f32_32x32x16_bf16(vf, pf[0][si], o[db][0], 0, 0, 0);
                o[db][1] = __builtin_amdgcn_mfma_f32_32x32x16_bf16(vf, pf[1][si], o[db][1], 0, 0, 0); }
        asm volatile("s_waitcnt lgkmcnt(0)" ::: "memory");
        if (more) DMA_V(t + 1);
    }
#undef DMA_K
#undef DMA_V
#pragma unroll
    for (int qb = 0; qb < 2; ++qb) { const float inv = 1.0f / swapsum(lrun[qb]); bf16_t* orow = Op + (size_t)(32 * qb + r32) * 1024 + 4 * hi;
#pragma unroll
        for (int db = 0; db < 2; ++db)
#pragma unroll
            for (int g4 = 0; g4 < 4; ++g4) { u32x2 w; w.x = pg8::cvt_pk_bf16(o[db][qb][4 * g4 + 0] * inv, o[db][qb][4 * g4 + 1] * inv); w.y = pg8::cvt_pk_bf16(o[db][qb][4 * g4 + 2] * inv, o[db][qb][4 * g4 + 3] * inv);
                *(u32x2*)(orow + 32 * db + 8 * g4) = w; } }
}

struct Args { const float* in[17]; float* out; unsigned char* ws; int ph_lo, ph_hi; };
static_assert(sizeof(Args) == 19 * 8 + 8, "Args has no padding");

__device__ __forceinline__ unsigned f2bf(float f) { unsigned u = __builtin_bit_cast(unsigned, f); return (u + 0x7fffu + ((u >> 16) & 1u)) >> 16; }
__device__ __forceinline__ unsigned pk2(float lo, float hi) { return f2bf(lo) | (f2bf(hi) << 16); }
__device__ __forceinline__ float wave_sum(float v) {
#pragma unroll
    for (int o = 1; o < 64; o <<= 1) v += __shfl_xor(v, o);
    return v;
}
__device__ __forceinline__ void transpose_item(const float* W, int ldn, int col0, int k0, const float* scale, bf16_t* WT, int K, int nrow0, LAS float* scr, int lane) {
#pragma unroll 8
    for (int i = 0; i < 32; ++i) { const int kk = 2 * i + (lane >> 5); float v = W[(size_t)(k0 + kk) * ldn + col0 + (lane & 31)]; if (scale) v *= scale[k0 + kk]; scr[kk * 33 + (lane & 31)] = v; }
    asm volatile("s_waitcnt lgkmcnt(0)" ::: "memory");
    const int c = lane & 7;
#pragma unroll
    for (int j = 0; j < 4; ++j) { const int n = (lane >> 3) + 8 * j; const LAS float* s = scr + (8 * c) * 33 + n;
        u32x4 o; o.x = pk2(s[0 * 33], s[1 * 33]); o.y = pk2(s[2 * 33], s[3 * 33]); o.z = pk2(s[4 * 33], s[5 * 33]); o.w = pk2(s[6 * 33], s[7 * 33]);
        *(u32x4*)(WT + (size_t)(nrow0 + n) * K + k0 + 8 * c) = o; }
    asm volatile("s_waitcnt lgkmcnt(0)" ::: "memory");
}

typedef const char __attribute__((address_space(4)))* kptr_t;
__device__ __forceinline__ const void* karg(int k) { kptr_t ka = (kptr_t)__builtin_amdgcn_kernarg_segment_ptr(); asm volatile("" : "+s"(ka)); return *(const void* const __attribute__((address_space(4)))*)(ka + 8 * k); }
#define KIN(k) ((const float*)karg(k))
#define KOUT() ((float*)karg(17))
#define KWS() ((unsigned char*)karg(18))

__global__ void __launch_bounds__(512, 2) fwd_kernel(Args args) {
    extern __shared__ __attribute__((aligned(16))) unsigned char lds_raw[];
    LAS unsigned char* lds = (LAS unsigned char*)lds_raw;
    cg::grid_group grid = cg::this_grid();
    const int lo = args.ph_lo, hi = args.ph_hi;
#ifndef PH_MASK
#define PH_MASK 0x1ff
#endif
#define IN(k) (((PH_MASK >> (k)) & 1) && lo <= (k) && (k) < hi)
#define SEAM(k) do { if (IN(k) && IN((k) + 1)) { asm volatile("s_waitcnt vmcnt(0)" ::: "memory"); grid.sync(); asm volatile("buffer_inv sc1\n\ts_waitcnt vmcnt(0)" ::: "memory"); } } while (0)
#define GEOM() int tid_ = threadIdx.x; asm volatile("" : "+v"(tid_)); const int tid = tid_, lane = tid & 63, wave = __builtin_amdgcn_readfirstlane(tid >> 6); const int G = gridDim.x, bx = blockIdx.x; \
    const int vcu = (G % 8 == 0) ? (bx % 8) * (G / 8) + bx / 8 : bx; (void)lane; (void)wave; (void)vcu; (void)tid

    if (IN(0)) {
        GEOM();
        unsigned char* ws = KWS();
        LAS float* scr = (LAS float*)(lds + wave * 16384);
        const int gw = vcu * 8 + wave, NGW = G * 8;
        constexpr int I_IN = (D / 64) * (NIN / 32), I_CO = (CD / 64) * (D / 32), I_AO = I_CO, I_OUT = (D / 64) * (D / 32), I_13 = (D / 64) * (NFF / 32), I_2 = (DFF / 64) * (D / 32);
        constexpr int NITEMS = I_IN + I_CO + I_AO + I_OUT + I_13 + I_2;
        for (int it = gw; it < NITEMS; it += NGW) {
            int r = it;
            if (r < I_IN) { const int nb = r % (NIN / 32), kb = r / (NIN / 32); const int tile = nb >> 3, w = nb & 7; int col0 = 32 * nb;
                if (tile >= 2 && tile < 6) col0 = (w < 4) ? (512 + 128 * (tile - 2) + 32 * w) : (1024 + 128 * (tile - 2) + 32 * (w - 4));
                transpose_item(KIN(6), NIN, col0, 64 * kb, nullptr, (bf16_t*)(ws + WS_WIN), D, 32 * nb, scr, lane); continue; } r -= I_IN;
            if (r < I_CO) { const int nb = r % (D / 32), kb = r / (D / 32); transpose_item(KIN(8), D, 32 * nb, 64 * kb, nullptr, (bf16_t*)(ws + WS_WCO), CD, 32 * nb, scr, lane); continue; } r -= I_CO;
            if (r < I_AO) { const int nb = r % (D / 32), kb = r / (D / 32); transpose_item(KIN(10), D, 32 * nb, 64 * kb, nullptr, (bf16_t*)(ws + WS_WAO), AD, 32 * nb, scr, lane); continue; } r -= I_AO;
            if (r < I_OUT) { const int nb = r % (D / 32), kb = r / (D / 32); transpose_item(KIN(11), D, 32 * nb, 64 * kb, nullptr, (bf16_t*)(ws + WS_WOUT), D, 32 * nb, scr, lane); continue; } r -= I_OUT;
            if (r < I_13) { const int nb = r % (NFF / 32), kb = r / (NFF / 32); const int tile = nb >> 3, w = nb & 7;
                const float* src = (w < 4) ? KIN(13) : KIN(14); const int col0 = 128 * tile + 32 * (w & 3);
                transpose_item(src, DFF, col0, 64 * kb, KIN(12), (bf16_t*)(ws + WS_W13), D, 32 * nb, scr, lane); continue; } r -= I_13;
            { const int nb = r % (D / 32), kb = r / (D / 32); transpose_item(KIN(15), D, 32 * nb, 64 * kb, nullptr, (bf16_t*)(ws + WS_W2), DFF, 32 * nb, scr, lane); }
        }
        {
            const float* x_prompt = KIN(0); const float* x_sample = KIN(1); const float* g_mix = KIN(5); bf16_t* R1 = (bf16_t*)(ws + WS_R1);
            for (int m = gw; m < M; m += NGW) {
                const float* xrow = (m < MP) ? x_prompt + (size_t)m * D : x_sample + (size_t)(m - MP) * D;
                const f32x4* xr = (const f32x4*)xrow + lane; const f32x4* gr = (const f32x4*)g_mix + lane;
                f32x4 v[4]; float s = 0.f;
#pragma unroll
                for (int j = 0; j < 4; ++j) { v[j] = xr[64 * j]; s += (v[j].x * v[j].x + v[j].y * v[j].y) + (v[j].z * v[j].z + v[j].w * v[j].w); }
                const float rstd = 1.0f / sqrtf(wave_sum(s) * (1.0f / D) + EPS);
                u32x2* o8 = (u32x2*)(R1 + (size_t)m * D) + lane;
#pragma unroll
                for (int j = 0; j < 4; ++j) { const f32x4 gg = gr[64 * j]; u32x2 w; w.x = pk2(v[j].x * rstd * gg.x, v[j].y * rstd * gg.y); w.y = pk2(v[j].z * rstd * gg.z, v[j].w * rstd * gg.w); o8[64 * j] = w; }
            }
        }
        {
            const float* cache_k = KIN(3); const float* cache_v = KIN(4); float* out = KOUT();
            for (int it = gw; it < 2 * NB * KVR; it += NGW) {
                const int isV = it >= NB * KVR, rr = isV ? it - NB * KVR : it, b = rr / KVR, r = rr % KVR;
                const float* src = (isV ? cache_v : cache_k) + (size_t)rr * 512 + lane * 8;
                const f32x4 a = *(const f32x4*)src, c = *(const f32x4*)(src + 4);
                u32x4 w; w.x = pk2(a.x, a.y); w.y = pk2(a.z, a.w); w.z = pk2(c.x, c.y); w.w = pk2(c.z, c.w);
                *(u32x4*)((bf16_t*)(ws + (isV ? WS_VS : WS_KS)) + (size_t)(b * KSR + r) * 512 + lane * 8) = w;
                if (r >= DSEQ) { float* d = out + (isV ? OFF_VS : OFF_KS) + (size_t)(b * KVR + r - DSEQ) * 512 + lane * 8; *(f32x4*)d = a; *(f32x4*)(d + 4) = c; }
            }
        }
    }
    SEAM(0);

    if (IN(1)) {
        unsigned char* ws = KWS();
        pg8::Gemm g{(const bf16_t*)(ws + WS_R1), (const bf16_t*)(ws + WS_WIN), M, NIN, D, D, D}; pg8::StaticOrder S; S.init(M, NIN, gridDim.x, blockIdx.x);
        EpiInProj E{ws, KOUT()};
        pg8::gemm_phase(lds, g, S, E);
    }
    SEAM(1);

    if (IN(2)) {
        GEOM();
        unsigned char* ws = KWS();
        LAS float* tbl = (LAS float*)(lds + TBL_OFF);
        { const float* rel_bias = KIN(9);
          for (int i = tid; i < NH * TBL_STRIDE; i += 512) { const int h = i / TBL_STRIDE, j = i % TBL_STRIDE; tbl[i] = rel_bias[h * 257 + (j < 256 ? j : 256)] * LOG2E; } }
        __syncthreads();
        volatile LAS int* misc = (volatile LAS int*)(lds + MISC_OFF);
        const unsigned lds0 = (unsigned)(uintptr_t)lds_raw;
        constexpr int NUNITS = NB * (SEQ / 64) + NB;
        bf16_t* R2 = (bf16_t*)(ws + WS_R2);
        for (;;) {
            __syncthreads();
            if (tid == 0) misc[0] = (int)atomicAdd((unsigned*)(ws + WS_CTL) + 64, 1u);
            __syncthreads();
            const int ui = misc[0];
            if (ui >= NUNITS) break;
            int b, c; bool smp = false;
            if (ui < 768) { const int grp = ui >> 8, w = ui & 255; b = w >> 3; c = 8 + 8 * grp + (w & 7); }
            else if (ui < 800) { smp = true; b = ui - 768; c = 0; }
            else { const int w = ui - 800; c = 7 - (w >> 5); b = w & 31; }
            const size_t row0 = smp ? (size_t)MP + (size_t)b * DSEQ : (size_t)b * SEQ + (size_t)c * 64;
            {
                const float* w_conv = KIN(7); const bf16_t* UB = (const bf16_t*)(ws + WS_U); const bf16_t* CB = (const bf16_t*)(ws + WS_CB);
                const int cb8 = (tid & 63) * 8, rg = tid >> 6;
                float w0[8], w1[8], w2[8];
#pragma unroll
                for (int e = 0; e < 8; ++e) { w0[e] = w_conv[cb8 + e]; w1[e] = w_conv[CD + cb8 + e]; w2[e] = w_conv[2 * CD + cb8 + e]; }
                f32x4 pa0, pa1, pb0, pb1;
                const size_t r0 = row0 + 8 * rg;
                if (rg == 0 && smp) { const float* sp = KIN(2) + (size_t)b * 2 * CD + cb8; pa0 = *(const f32x4*)sp; pa1 = *(const f32x4*)(sp + 4); pb0 = *(const f32x4*)(sp + CD); pb1 = *(const f32x4*)(sp + CD + 4); }
                else if (rg == 0 && c == 0) { pa0 = pa1 = pb0 = pb1 = (f32x4){0.f, 0.f, 0.f, 0.f}; }
                else { unpack8(*(const u32x4*)(UB + (r0 - 2) * CD + cb8), pa0, pa1); unpack8(*(const u32x4*)(UB + (r0 - 1) * CD + cb8), pb0, pb1); }
#pragma unroll
                for (int i = 0; i < 8; ++i) {
                    f32x4 c0, c1, e0, e1; unpack8(*(const u32x4*)(UB + (r0 + i) * CD + cb8), c0, c1); unpack8(*(const u32x4*)(CB + (r0 + i) * CD + cb8), e0, e1);
                    f32x4 y0, y1;
#pragma unroll
                    for (int e = 0; e < 4; ++e) { y0[e] = e0[e] * (w0[e] * pa0[e] + w1[e] * pb0[e] + w2[e] * c0[e]); y1[e] = e1[e] * (w0[4 + e] * pa1[e] + w1[4 + e] * pb1[e] + w2[4 + e] * c1[e]); }
                    *(u32x4*)(R2 + (r0 + i) * D + cb8) = pack8(y0, y1);
                    pa0 = pb0; pa1 = pb1; pb0 = c0; pb1 = c1;
                }
            }
            EPI_FENCE();
            {
                const int h = wave; int ntiles; const bf16_t *Kp, *Vp;
                if (smp) { ntiles = 9; Kp = (const bf16_t*)(ws + WS_KS) + (size_t)b * KSR * 512 + h * 64; Vp = (const bf16_t*)(ws + WS_VS) + (size_t)b * KSR * 512 + h * 64; }
                else { const int c0 = c > 8 ? c - 8 : 0; ntiles = c - c0 + 1; const size_t kr = (size_t)b * SEQ + (size_t)c0 * 64; Kp = (const bf16_t*)(ws + WS_KB) + kr * 512 + h * 64; Vp = (const bf16_t*)(ws + WS_VB) + kr * 512 + h * 64; }
                attn_unit(lds + wave * 16384, lds0 + wave * 16384, tbl + h * TBL_STRIDE, (const bf16_t*)(ws + WS_Q) + row0 * 512 + h * 64, Kp, Vp, ntiles, R2 + row0 * D + 512 + h * 64, lane);
            }
        }
    }
    SEAM(2);

    if (IN(3)) {
        unsigned char* ws = KWS();
        pg8::Gemm g{(const bf16_t*)(ws + WS_R2), (const bf16_t*)(ws + WS_WCO), M, D, CD, D, CD}; pg8::StaticOrder S; S.init(M, D, gridDim.x, blockIdx.x);
        EpiGate<false> E{ws};
        pg8::gemm_phase(lds, g, S, E);
    }
    SEAM(3);
    if (IN(4)) {
        unsigned char* ws = KWS();
        pg8::Gemm g{(const bf16_t*)(ws + WS_R2) + 512, (const bf16_t*)(ws + WS_WAO), M, D, AD, D, AD}; pg8::StaticOrder S; S.init(M, D, gridDim.x, blockIdx.x);
        EpiGate<true> E{ws};
        pg8::gemm_phase(lds, g, S, E);
    }
    SEAM(4);
    if (IN(5)) {
        unsigned char* ws = KWS();
        pg8::Gemm g{(const bf16_t*)(ws + WS_R1), (const bf16_t*)(ws + WS_WOUT), M, D, D, D, D}; pg8::StaticOrder S; S.init(M, D, gridDim.x, blockIdx.x);
        EpiResid<true> E{KIN(0), KIN(1), ws, nullptr};
        pg8::gemm_phase(lds, g, S, E);
    }
    SEAM(5);
    if (IN(6)) {
        unsigned char* ws = KWS();
        pg8::Gemm g{(const bf16_t*)(ws + WS_R2), (const bf16_t*)(ws + WS_W13), M, NFF, D, D, D}; pg8::StaticOrder S; S.init(M, NFF, gridDim.x, blockIdx.x);
        EpiSwiGLU E{ws};
        pg8::gemm_phase(lds, g, S, E);
    }
    SEAM(6);
    if (IN(7)) {
        unsigned char* ws = KWS();
        pg8::Gemm g{(const bf16_t*)(ws + WS_H), (const bf16_t*)(ws + WS_W2), M, D, DFF, DFF, DFF}; pg8::StaticOrder S; S.init(M, D, gridDim.x, blockIdx.x);
        EpiResid<false> E{nullptr, nullptr, ws, KOUT()};
        pg8::gemm_phase(lds, g, S, E);
    }
    SEAM(7);
    if (IN(8)) {
        GEOM();
        const float* SS2 = (const float*)(KWS() + CTL_SS2); float* out = KOUT();
        const int gw = vcu * 8 + wave, NGW = G * 8;
        const f32x4* gr = (const f32x4*)KIN(16) + lane;
        f32x4 gg[4];
#pragma unroll
        for (int j = 0; j < 4; ++j) gg[j] = gr[64 * j];
        for (int m = gw; m < M; m += NGW) {
            f32x4* yr = (f32x4*)(out + OFF_Y + (size_t)m * D) + lane;
            const float rs = 1.0f / sqrtf(SS2[m] * (1.0f / D) + EPS);
#pragma unroll
            for (int j = 0; j < 4; ++j) { f32x4 v = yr[64 * j]; v = v * rs * gg[j]; yr[64 * j] = v; }
        }
    }
#ifdef DBG_DUMP_OFF
    {
        asm volatile("s_waitcnt vmcnt(0)" ::: "memory"); grid.sync(); asm volatile("buffer_inv sc1\n\ts_waitcnt vmcnt(0)" ::: "memory");
        GEOM();
        const bf16_t* src = (const bf16_t*)(KWS() + (size_t)DBG_DUMP_OFF); float* out = KOUT();
        const int gw = vcu * 8 + wave, NGW = G * 8;
        for (int m = gw; m < M; m += NGW) {
#pragma unroll
            for (int j = 0; j < 2; ++j) { f32x4 a, b; unpack8(*(const u32x4*)(src + (size_t)m * D + j * 512 + lane * 8), a, b); float* d = out + (size_t)m * D + j * 512 + lane * 8; *(f32x4*)d = a; *(f32x4*)(d + 4) = b; }
        }
    }
#endif
#undef IN
#undef SEAM
}

#ifndef N_LAUNCHES
#define N_LAUNCHES 1
#endif
constexpr int NPHASE = 9;
extern "C" void kernel_launch(void* const* d_in, const int* in_sizes, int n_in, void* d_out, int out_size, void* d_ws, size_t ws_size, hipStream_t stream) {
    static int grid = 0;
    if (grid == 0) {
        if (n_in != 17 || ws_size < WS_END) { fprintf(stderr, "kernel_launch: unexpected n_in %d / ws %zu\n", n_in, ws_size); grid = -1; return; }
        int dev = 0, cus = 0, per_cu = 0;
        (void)hipGetDevice(&dev); (void)hipDeviceGetAttribute(&cus, hipDeviceAttributeMultiprocessorCount, dev);
        if (hipFuncSetAttribute((const void*)fwd_kernel, hipFuncAttributeMaxDynamicSharedMemorySize, LDS_BYTES) != hipSuccess) { fprintf(stderr, "kernel_launch: hipFuncSetAttribute failed\n"); grid = -1; return; }
        if (hipOccupancyMaxActiveBlocksPerMultiprocessor(&per_cu, (const void*)fwd_kernel, 512, LDS_BYTES) != hipSuccess || per_cu < 1) { fprintf(stderr, "kernel_launch: occupancy query says %d\n", per_cu); per_cu = 1; }
        (void)hipGetLastError();
        grid = cus;
    }
    if (grid < 0) return;
    (void)hipMemsetAsync((char*)d_ws + WS_CTL, 0, CTL_BYTES, stream);
    Args a{};
    for (int i = 0; i < 17; ++i) a.in[i] = (const float*)d_in[i];
    a.out = (float*)d_out; a.ws = (unsigned char*)d_ws;
#if N_LAUNCHES == 1
#ifndef PH_HI
#define PH_HI NPHASE
#endif
    a.ph_lo = 0; a.ph_hi = PH_HI;
    void* kargs[] = {&a};
    hipError_t e = hipLaunchCooperativeKernel((const void*)fwd_kernel, dim3(grid), dim3(512), kargs, LDS_BYTES, stream);
    if (e != hipSuccess) fprintf(stderr, "cooperative launch failed: %s (grid %d)\n", hipGetErrorString(e), grid);
#else
    for (int p = 0; p < NPHASE; ++p) { a.ph_lo = p; a.ph_hi = p + 1; hipLaunchKernelGGL(fwd_kernel, dim3(grid), dim3(512), LDS_BYTES, stream, a); }
#endif
}
```

```cpp
#include <hip/hip_runtime.h>
#include <cstdio>
#include <cstdint>

#define LAS __attribute__((address_space(3)))
typedef unsigned short bf16_t;
typedef short bf16x8 __attribute__((ext_vector_type(8)));
typedef short s16x4 __attribute__((ext_vector_type(4)));
typedef float f32x4 __attribute__((ext_vector_type(4)));
typedef float f32x16 __attribute__((ext_vector_type(16)));
typedef unsigned u32x4 __attribute__((ext_vector_type(4)));
typedef unsigned u32x2 __attribute__((ext_vector_type(2)));

constexpr int D = 1024, NB = 32, SEQ = 2048, DSEQ = 64, MP = NB * SEQ, MS = NB * DSEQ, M = MP + MS;
constexpr int CD = 512, AD = 512, NH = 8, HD = 64, DFF = 2816, NIN = 5120, NFF = 2 * DFF, KVR = 512, KSR = KVR + DSEQ;
constexpr float EPS = 1e-6f;
constexpr float LOG2E = 1.4426950408889634f;
constexpr float C2 = 0.125f * LOG2E;
constexpr size_t OFF_Y = 0, OFF_CONVP = (size_t)M * D, OFF_KP = OFF_CONVP + (size_t)NB * 2 * CD, OFF_VP = OFF_KP + (size_t)NB * KVR * AD,
                 OFF_CONVS = OFF_VP + (size_t)NB * KVR * AD, OFF_KS = OFF_CONVS + (size_t)NB * 2 * CD, OFF_VS = OFF_KS + (size_t)NB * KVR * AD;
constexpr size_t MiB = 1u << 20;
constexpr size_t WS_CTL = 0, CTL_BYTES = 1 * MiB;
constexpr size_t CTL_SS1 = 4096, CTL_SS2 = CTL_SS1 + (size_t)M * 4;
constexpr size_t CTL_BAR = 614400;
static_assert(CTL_SS2 + (size_t)M * 4 <= CTL_BAR && CTL_BAR + 3456 * 4 <= CTL_BYTES, "ctl");
constexpr size_t WS_WIN = 2 * MiB, WS_WCO = 12 * MiB, WS_WAO = 13 * MiB, WS_WOUT = 14 * MiB, WS_W13 = 16 * MiB, WS_W2 = 27 * MiB;
constexpr size_t WS_R2 = 34 * MiB, WS_R1 = 166 * MiB;
constexpr size_t WS_CB = 298 * MiB, WS_U = 364 * MiB, WS_Q = 430 * MiB, WS_KB = 496 * MiB, WS_VB = 562 * MiB;
constexpr size_t WS_SGA = 628 * MiB, WS_SGB = 760 * MiB;
constexpr size_t WS_KS = 892 * MiB, WS_VS = 910 * MiB;
constexpr size_t WS_H = 166 * MiB;
constexpr size_t WS_X1 = 628 * MiB;
constexpr size_t WS_END = 928 * MiB;
static_assert(WS_H + (size_t)M * DFF * 2 <= WS_X1 && WS_X1 + (size_t)M * D * 4 <= WS_KS, "ws map");

constexpr int RING_BYTES = 131072, TBL_OFF = RING_BYTES, TBL_STRIDE = 320, MISC_OFF = TBL_OFF + NH * TBL_STRIDE * 4, LDS_BYTES = 147456;
static_assert(MISC_OFF + 256 <= LDS_BYTES, "lds");

namespace pg8 {
constexpr int BM = 256, BK = 64, HALF = 128, HTB = HALF * BK * 2, NXCD = 8, WGM = 8;
__host__ __device__ __forceinline__ int lds_byte(int r, int c) { const int st = (r >> 4) * 2 + (c >> 5), rr = r & 15, cc = c & 31, ob = rr * 64 + cc * 2; return st * 1024 + (ob ^ (((ob >> 9) & 1) << 5)); }
__host__ __device__ __forceinline__ void stage_rc(int b, int& R, int& C) { const int st = b / 1024, sb = b % 1024, swz = sb ^ (((sb >> 9) & 1) << 5); R = (st >> 1) * 16 + swz / 64; C = (st & 1) * 32 + (swz % 64) / 2; }
__host__ __device__ __forceinline__ int perm32(int rho) { const int n = rho >> 4, i = rho & 15; return 8 * (i >> 2) + 4 * n + (i & 3); }

struct Unit { int pm, pn; };
struct Gemm { const bf16_t* A; const bf16_t* Bt; int M, N, K, lda, ldb; };

struct StaticOrder {
    int nM, nN, nwg, G, c;
    __host__ __device__ void init(int M_, int N_, int G_, int c_) { nM = M_ / BM; nN = N_ / BM; nwg = nM * nN; G = G_; c = c_; }
    __host__ __device__ bool next(int i, Unit& u) const {
        const long L = (long)i * G + c; if (L >= nwg) return false;
        int wgid = (int)L; { const int q = nwg / NXCD, r = nwg % NXCD, xcd = wgid % NXCD, off = wgid / NXCD; wgid = (xcd < r ? xcd * (q + 1) : r * (q + 1) + (xcd - r) * q) + off; }
        const int nig = WGM * nN, gid = wgid / nig, fm = gid * WGM, gsz = (nM - fm) < WGM ? (nM - fm) : WGM;
        u.pm = fm + ((wgid % nig) % gsz); u.pn = (wgid % nig) / gsz; return true;
    }
};

typedef float f32x2_t __attribute__((ext_vector_type(2))); typedef __bf16 bf16x2_t __attribute__((ext_vector_type(2)));
__device__ __forceinline__ unsigned cvt_pk_bf16(float lo, float hi) { f32x2_t v = {lo, hi}; bf16x2_t b = __builtin_convertvector(v, bf16x2_t); return __builtin_bit_cast(unsigned, b); }
__device__ __forceinline__ u32x4 pack8(f32x4 v0, f32x4 v1) { u32x4 w; w.x = cvt_pk_bf16(v0[0], v0[1]); w.y = cvt_pk_bf16(v0[2], v0[3]); w.z = cvt_pk_bf16(v1[0], v1[1]); w.w = cvt_pk_bf16(v1[2], v1[3]); return w; }
__device__ __forceinline__ void unpack8(u32x4 w, f32x4& v0, f32x4& v1) {
    v0[0] = __uint_as_float(w.x << 16); v0[1] = __uint_as_float(w.x & 0xffff0000u); v0[2] = __uint_as_float(w.y << 16); v0[3] = __uint_as_float(w.y & 0xffff0000u);
    v1[0] = __uint_as_float(w.z << 16); v1[1] = __uint_as_float(w.z & 0xffff0000u); v1[2] = __uint_as_float(w.w << 16); v1[3] = __uint_as_float(w.w & 0xffff0000u);
}

template <class Epi>
__device__ __forceinline__ void gemm_phase(LAS unsigned char* lds, const Gemm g, const StaticOrder& S, const Epi& E) {
    int tid_ = threadIdx.x; asm volatile("" : "+v"(tid_));
    const int tid = tid_, wid = __builtin_amdgcn_readfirstlane(tid >> 6), lane = tid & 63, wr = wid >> 2, wc = wid & 3, fr = lane & 15, fq = lane >> 4;
    const int K = g.K, nt = K / BK;
    unsigned voffA[2], voffB[2];
#pragma unroll
    for (int i = 0; i < 2; ++i) { int R, C; stage_rc(tid * 16 + i * 8192, R, C); const int Rb = (R & ~31) + perm32(R & 31);
        voffA[i] = (unsigned)(R * g.lda + C) * 2u; voffB[i] = (unsigned)(Rb * g.ldb + C) * 2u; }
    const size_t kstep = (size_t)(BK * 2);
    const size_t hstepA = (size_t)HALF * g.lda * 2, hstepB = (size_t)HALF * g.ldb * 2;
    const size_t tstepA = 2 * hstepA, tstepB = 2 * hstepB;
    const unsigned ldsw = (unsigned)wid * 1024u;
    const int aoff = lds_byte(wr * 64 + fr, fq * 8), boff = lds_byte(wc * 32 + fr, fq * 8);
#define PG8_SA(b, h) (((b) * 2 + (h)) * HTB)
#define PG8_SB(b, h) ((4 + (b) * 2 + (h)) * HTB)
#define PG8_STAGE(bufoff, gbase, voff) do { _Pragma("unroll") for (int _i = 0; _i < 2; ++_i) \
        __builtin_amdgcn_global_load_lds((const unsigned*)((const char*)(gbase) + (voff)[_i]), (LAS unsigned*)(lds + (bufoff) + ldsw + _i * 8192), 16, 0, 0); } while (0)
#define PG8_LDA(dst, b, h) do { _Pragma("unroll") for (int m = 0; m < 4; ++m) _Pragma("unroll") for (int k = 0; k < 2; ++k) dst[m][k] = *(const LAS bf16x8*)(lds + PG8_SA(b, h) + aoff + m * 2048 + k * 1024); } while (0)
#define PG8_LDB(dst, b, h) do { _Pragma("unroll") for (int n = 0; n < 2; ++n) _Pragma("unroll") for (int k = 0; k < 2; ++k) dst[n][k] = *(const LAS bf16x8*)(lds + PG8_SB(b, h) + boff + n * 2048 + k * 1024); } while (0)
#define PG8_MMA(ai, bj, At, Bt) do { __builtin_amdgcn_s_setprio(1); _Pragma("unroll") for (int m = 0; m < 4; ++m) _Pragma("unroll") for (int n = 0; n < 2; ++n) _Pragma("unroll") for (int k = 0; k < 2; ++k) \
        acc[ai][bj][m][n] = __builtin_amdgcn_mfma_f32_16x16x32_bf16(Bt[n][k], At[m][k], acc[ai][bj][m][n], 0, 0, 0); __builtin_amdgcn_s_setprio(0); } while (0)
#define PG8_WAIT_V(n) asm volatile("s_waitcnt vmcnt(" #n ")" ::: "memory")
#define PG8_WAIT_L(n) asm volatile("s_waitcnt lgkmcnt(" #n ")" ::: "memory")
#define PG8_BAR __builtin_amdgcn_s_barrier()
#define PG8_SCHED __builtin_amdgcn_sched_barrier(0)
    Unit cur, nxt; int ui = 0;
    if (!S.next(0, cur)) return;
    f32x4 acc[2][2][4][2];
#pragma unroll
    for (int a = 0; a < 2; ++a)
#pragma unroll
        for (int b = 0; b < 2; ++b)
#pragma unroll
            for (int m = 0; m < 4; ++m)
#pragma unroll
                for (int n = 0; n < 2; ++n) acc[a][b][m][n] = (f32x4){0.f, 0.f, 0.f, 0.f};
    bf16x8 At[4][2], B0[2][2], B1[2][2];
    const char* cA = (const char*)g.A + (size_t)cur.pm * tstepA; const char* cB = (const char*)g.Bt + (size_t)cur.pn * tstepB;
    PG8_STAGE(PG8_SB(0, 0), cB, voffB); PG8_STAGE(PG8_SB(0, 1), cB + hstepB, voffB); PG8_STAGE(PG8_SA(0, 0), cA, voffA); PG8_STAGE(PG8_SA(0, 1), cA + hstepA, voffA);
    if (wr == 1) PG8_BAR;
    PG8_WAIT_V(2); PG8_BAR;
    PG8_STAGE(PG8_SB(1, 0), cB + kstep, voffB); PG8_STAGE(PG8_SA(1, 0), cA + kstep, voffA); PG8_STAGE(PG8_SB(1, 1), cB + hstepB + kstep, voffB);
    PG8_WAIT_V(6); PG8_BAR;
    for (;;) {
        const bool has_next = S.next(ui + 1, nxt);
        const char* nA = has_next ? (const char*)g.A + (size_t)nxt.pm * tstepA : cA; const char* nB = has_next ? (const char*)g.Bt + (size_t)nxt.pn * tstepB : cB;
        for (int t = 0; t < nt; t += 2) {
            const bool last = (t == nt - 2);
            const char* a1 = cA + (size_t)(t + 1) * kstep;
            const char* a2 = last ? nA : cA + (size_t)(t + 2) * kstep; const char* b2 = last ? nB : cB + (size_t)(t + 2) * kstep;
            const char* a3 = a2 + kstep; const char* b3 = b2 + kstep;
            PG8_LDB(B0, 0, 0); PG8_LDB(B1, 0, 1); PG8_SCHED; PG8_LDA(At, 0, 0); PG8_STAGE(PG8_SA(1, 1), a1 + hstepA, voffA);
            PG8_WAIT_V(8); PG8_WAIT_L(0); PG8_BAR; PG8_MMA(0, 0, At, B0); PG8_MMA(0, 1, At, B1); PG8_BAR; PG8_SCHED;
            PG8_LDA(At, 0, 1); PG8_STAGE(PG8_SB(0, 0), b2, voffB); PG8_STAGE(PG8_SB(0, 1), b2 + hstepB, voffB); PG8_STAGE(PG8_SA(0, 0), a2, voffA);
            PG8_WAIT_V(8); PG8_WAIT_L(0); PG8_BAR; PG8_MMA(1, 0, At, B0); PG8_MMA(1, 1, At, B1); PG8_BAR; PG8_SCHED;
            PG8_LDB(B0, 1, 0); PG8_LDB(B1, 1, 1); PG8_SCHED; PG8_LDA(At, 1, 0); PG8_STAGE(PG8_SA(0, 1), a2 + hstepA, voffA);
            PG8_WAIT_V(8); PG8_WAIT_L(0); PG8_BAR; PG8_MMA(0, 0, At, B0); PG8_MMA(0, 1, At, B1); PG8_BAR; PG8_SCHED;
            PG8_LDA(At, 1, 1); PG8_STAGE(PG8_SB(1, 0), b3, voffB); PG8_STAGE(PG8_SB(1, 1), b3 + hstepB, voffB); PG8_STAGE(PG8_SA(1, 0), a3, voffA);
            PG8_WAIT_V(8); PG8_WAIT_L(0); PG8_BAR; PG8_MMA(1, 0, At, B0); PG8_MMA(1, 1, At, B1); PG8_BAR; PG8_SCHED;
        }
        if (wr == 0) PG8_BAR;
        E(acc, cur, wr, wc, fr, fq);
        if (!has_next) break;
#pragma unroll
        for (int a = 0; a < 2; ++a)
#pragma unroll
            for (int b = 0; b < 2; ++b)
#pragma unroll
                for (int m = 0; m < 4; ++m)
#pragma unroll
                    for (int n = 0; n < 2; ++n) acc[a][b][m][n] = (f32x4){0.f, 0.f, 0.f, 0.f};
        cur = nxt; cA = nA; cB = nB; ++ui;
        if (wr == 1) PG8_BAR;
    }
    PG8_WAIT_V(0);
    PG8_BAR;
#undef PG8_SA
#undef PG8_SB
#undef PG8_STAGE
#undef PG8_LDA
#undef PG8_LDB
#undef PG8_MMA
#undef PG8_WAIT_V
#undef PG8_WAIT_L
#undef PG8_BAR
#undef PG8_SCHED
}
}
using pg8::Unit; using pg8::pack8; using pg8::unpack8;

#define EPI_FENCE() asm volatile("" ::: "memory")
__device__ __forceinline__ float sigmoidf_(float x) { return __builtin_amdgcn_rcpf(1.0f + __builtin_amdgcn_exp2f(-x * LOG2E)); }

#define LAUNDER_V(x) asm volatile("" : "+v"(x))
#define ST16(base, off, v) (*(u32x4*)((char*)(base) + (off)) = (v))
#define ST16F(base, off, v) (*(f32x4*)((char*)(base) + (off)) = (v))
#define LD16(base, off) (*(const u32x4*)((const char*)(base) + (off)))
#define LD16F(base, off) (*(const f32x4*)((const char*)(base) + (off)))
struct EpiInProj {
    unsigned char* ws; float* out;
    __device__ __forceinline__ void operator()(const f32x4 (&acc)[2][2][4][2], const Unit& u, int wr, int wc, int fr, int fq) const {
        const int pn = u.pn, pm = u.pm;
        const bool sample = pm >= MP / 256;
        unsigned lr0 = wr * 64 + fr, col8 = wc * 32 + 8 * fq;
        if (pn >= 2 && pn < 6) {
            LAUNDER_V(lr0); LAUNDER_V(col8);
            unsigned char* U = ws + WS_U + ((size_t)pm * 256 * CD + 128 * (pn - 2)) * 2;
            const unsigned vo = (lr0 * CD + col8) * 2;
#pragma unroll
            for (int ai = 0; ai < 2; ++ai) {
#pragma unroll
                for (int m = 0; m < 4; ++m) {
                    const f32x4 a0 = acc[ai][0][m][0] * acc[ai][1][m][0], a1 = acc[ai][0][m][1] * acc[ai][1][m][1];
                    ST16(U, vo + (ai * 128 + m * 16) * CD * 2, pack8(a0, a1));
                    if (m == 3) {
                        const int lr = (int)lr0 + ai * 128 + 48; float* d = nullptr; const int ch0 = 128 * (pn - 2) + (int)col8;
                        if (!sample) { if ((pm & 7) == 7 && lr >= 254) d = out + OFF_CONVP + ((size_t)((pm >> 3) * 2 + (lr - 254)) * CD + ch0); }
                        else { const int t = lr & 63, b = (pm - MP / 256) * 4 + (lr >> 6); if (t >= DSEQ - 2) d = out + OFF_CONVS + ((size_t)(b * 2 + (t - (DSEQ - 2))) * CD + ch0); }
                        if (d) { *(f32x4*)d = a0; *(f32x4*)(d + 4) = a1; }
                    }
                }
                EPI_FENCE();
            }
        } else if (pn < 8) {
            LAUNDER_V(lr0); LAUNDER_V(col8);
            unsigned char* dst = ws + (pn < 2 ? WS_CB : WS_Q) + ((size_t)pm * 256 * 512 + 256 * (pn & 1)) * 2; const float sc = pn < 2 ? 1.0f : C2;
            const unsigned vo = (lr0 * 512 + col8) * 2;
#pragma unroll
            for (int ai = 0; ai < 2; ++ai) {
#pragma unroll
                for (int m = 0; m < 4; ++m)
#pragma unroll
                    for (int bj = 0; bj < 2; ++bj) ST16(dst, vo + ((ai * 128 + m * 16) * 512 + bj * 128) * 2, pack8(acc[ai][bj][m][0] * sc, acc[ai][bj][m][1] * sc));
                EPI_FENCE();
            }
        } else if (pn < 12) {
            LAUNDER_V(lr0); LAUNDER_V(col8);
            const bool isV = pn >= 10; const int cb0 = 256 * (pn & 1);
            if (!sample) {
                unsigned char* db = ws + (isV ? WS_VB : WS_KB) + ((size_t)pm * 256 * 512 + cb0) * 2;
                const unsigned vo = (lr0 * 512 + col8) * 2;
#pragma unroll
                for (int ai = 0; ai < 2; ++ai) {
#pragma unroll
                    for (int m = 0; m < 4; ++m)
#pragma unroll
                        for (int bj = 0; bj < 2; ++bj) ST16(db, vo + ((ai * 128 + m * 16) * 512 + bj * 128) * 2, pack8(acc[ai][bj][m][0], acc[ai][bj][m][1]));
                    EPI_FENCE();
                }
                if ((pm & 7) >= 6) {
                    float* df = out + (isV ? OFF_VP : OFF_KP) + (size_t)((pm >> 3) * KVR + ((pm & 7) - 6) * 256) * 512 + cb0;
                    const unsigned vf = (lr0 * 512 + col8) * 4;
#pragma unroll
                    for (int ai = 0; ai < 2; ++ai) {
#pragma unroll
                        for (int m = 0; m < 4; ++m)
#pragma unroll
                            for (int bj = 0; bj < 2; ++bj) { const unsigned o = vf + ((ai * 128 + m * 16) * 512 + bj * 128) * 4; ST16F(df, o, acc[ai][bj][m][0]); ST16F(df, o + 16, acc[ai][bj][m][1]); }
                        EPI_FENCE();
                    }
                }
            } else {
                const unsigned t0 = lr0 & 63, bq = lr0 >> 6;
                const unsigned vo = (t0 * 512 + col8) * 2, vf = (t0 * 512 + col8) * 4;
#pragma unroll
                for (int ai = 0; ai < 2; ++ai) {
                    const int b = (pm - MP / 256) * 4 + __builtin_amdgcn_readfirstlane(bq) + 2 * ai;
                    unsigned char* db = ws + (isV ? WS_VS : WS_KS) + ((size_t)(b * KSR + KVR) * 512 + cb0) * 2;
                    float* df = out + (isV ? OFF_VS : OFF_KS) + (size_t)(b * KVR + (KVR - DSEQ)) * 512 + cb0;
#pragma unroll
                    for (int m = 0; m < 4; ++m)
#pragma unroll
                        for (int bj = 0; bj < 2; ++bj) { ST16(db, vo + (m * 16 * 512 + bj * 128) * 2, pack8(acc[ai][bj][m][0], acc[ai][bj][m][1]));
                            const unsigned o = vf + (m * 16 * 512 + bj * 128) * 4; ST16F(df, o, acc[ai][bj][m][0]); ST16F(df, o + 16, acc[ai][bj][m][1]); }
                    EPI_FENCE();
                }
            }
        } else {
            LAUNDER_V(lr0); LAUNDER_V(col8);
            unsigned char* dst = ws + (pn >= 16 ? WS_SGB : WS_SGA) + ((size_t)pm * 256 * D + 256 * (pn & 3)) * 2;
            const unsigned vo = (lr0 * D + col8) * 2;
#pragma unroll
            for (int ai = 0; ai < 2; ++ai) {
#pragma unroll
                for (int m = 0; m < 4; ++m)
#pragma unroll
                    for (int bj = 0; bj < 2; ++bj) { f32x4 v0 = acc[ai][bj][m][0], v1 = acc[ai][bj][m][1];
#pragma unroll
                        for (int e = 0; e < 4; ++e) { v0[e] = sigmoidf_(v0[e]); v1[e] = sigmoidf_(v1[e]); }
                        ST16(dst, vo + ((ai * 128 + m * 16) * D + bj * 128) * 2, pack8(v0, v1)); }
                EPI_FENCE();
            }
        }
    }
};

template <bool SECOND> struct EpiGate {
    unsigned char* ws;
    __device__ __forceinline__ void operator()(const f32x4 (&acc)[2][2][4][2], const Unit& u, int wr, int wc, int fr, int fq) const {
        const size_t tb = ((size_t)u.pm * 256 * D + u.pn * 256) * 2;
        const unsigned char* G = ws + (SECOND ? WS_SGB : WS_SGA) + tb; unsigned char* T = ws + WS_R1 + tb;
        unsigned lr0 = wr * 64 + fr, col8 = wc * 32 + 8 * fq; LAUNDER_V(lr0); LAUNDER_V(col8);
        const unsigned vo = (lr0 * D + col8) * 2;
#pragma unroll
        for (int ai = 0; ai < 2; ++ai)
#pragma unroll
            for (int m = 0; m < 4; ++m) {
                u32x4 gw[2], tw[2];
#pragma unroll
                for (int bj = 0; bj < 2; ++bj) { const unsigned o = vo + ((ai * 128 + m * 16) * D + bj * 128) * 2; gw[bj] = LD16(G, o); if (SECOND) tw[bj] = LD16(T, o); }
#pragma unroll
                for (int bj = 0; bj < 2; ++bj) { const unsigned o = vo + ((ai * 128 + m * 16) * D + bj * 128) * 2;
                    f32x4 g0, g1; unpack8(gw[bj], g0, g1); f32x4 v0 = acc[ai][bj][m][0] * g0, v1 = acc[ai][bj][m][1] * g1;
                    if (SECOND) { f32x4 t0, t1; unpack8(tw[bj], t0, t1); v0 += t0; v1 += t1; }
                    ST16(T, o, pack8(v0, v1)); }
                if (m & 1) EPI_FENCE(); }
    }
};

template <bool FIRST> struct EpiResid {
    const float* xp; const float* xs;
    unsigned char* ws; float* out;
    __device__ __forceinline__ void operator()(const f32x4 (&acc)[2][2][4][2], const Unit& u, int wr, int wc, int fr, int fq) const {
        const size_t grow0 = (size_t)u.pm * 256; const int cb = u.pn * 256;
        const float* src; float* of; float* ss;
        if (FIRST) { src = ((u.pm >= MP / 256) ? xs + (grow0 - MP) * D : xp + grow0 * D) + cb; of = (float*)(ws + WS_X1) + grow0 * D + cb; ss = (float*)(ws + CTL_SS1) + grow0; }
        else { src = (const float*)(ws + WS_X1) + grow0 * D + cb; of = out + OFF_Y + grow0 * D + cb; ss = (float*)(ws + CTL_SS2) + grow0; }
        unsigned char* ob = ws + WS_R2 + (grow0 * D + cb) * 2;
        unsigned lr0 = wr * 64 + fr, col8 = wc * 32 + 8 * fq; LAUNDER_V(lr0); LAUNDER_V(col8);
        const unsigned ve = lr0 * D + col8;
#pragma unroll
        for (int ai = 0; ai < 2; ++ai)
#pragma unroll
            for (int m = 0; m < 4; ++m) {
                f32x4 r[2][2];
#pragma unroll
                for (int bj = 0; bj < 2; ++bj) { const unsigned o = (ve + (ai * 128 + m * 16) * D + bj * 128) * 4; r[bj][0] = LD16F(src, o); r[bj][1] = LD16F(src, o + 16); }
                float s = 0.f;
#pragma unroll
                for (int bj = 0; bj < 2; ++bj) { const unsigned e = ve + (ai * 128 + m * 16) * D + bj * 128;
                    const f32x4 v0 = acc[ai][bj][m][0] + r[bj][0], v1 = acc[ai][bj][m][1] + r[bj][1];
                    ST16F(of, e * 4, v0); ST16F(of, e * 4 + 16, v1);
                    if (FIRST) ST16(ob, e * 2, pack8(v0, v1));
                    s += (v0[0] * v0[0] + v0[1] * v0[1]) + (v0[2] * v0[2] + v0[3] * v0[3]) + (v1[0] * v1[0] + v1[1] * v1[1]) + (v1[2] * v1[2] + v1[3] * v1[3]); }
                s += __shfl_xor(s, 16); s += __shfl_xor(s, 32);
                if (fq == 0) unsafeAtomicAdd(ss + lr0 + ai * 128 + m * 16, s);
                if (m & 1) EPI_FENCE(); }
    }
};

struct EpiSwiGLU {
    unsigned char* ws;
    __device__ __forceinline__ void operator()(const f32x4 (&acc)[2][2][4][2], const Unit& u, int wr, int wc, int fr, int fq) const {
        const size_t grow0 = (size_t)u.pm * 256;
        const float* ss = (const float*)(ws + CTL_SS1) + grow0; unsigned char* H = ws + WS_H + (grow0 * DFF + u.pn * 128) * 2;
        unsigned lr0 = wr * 64 + fr, col8 = wc * 32 + 8 * fq; LAUNDER_V(lr0); LAUNDER_V(col8);
        const unsigned vo = (lr0 * DFF + col8) * 2;
        float rs[2][4];
#pragma unroll
        for (int ai = 0; ai < 2; ++ai)
#pragma unroll
            for (int m = 0; m < 4; ++m) rs[ai][m] = __builtin_amdgcn_rsqf(ss[lr0 + ai * 128 + m * 16] * (1.0f / D) + EPS);
#pragma unroll
        for (int ai = 0; ai < 2; ++ai)
#pragma unroll
            for (int m = 0; m < 4; ++m) { const float r = rs[ai][m]; f32x4 h[2];
#pragma unroll
                for (int n = 0; n < 2; ++n)
#pragma unroll
                    for (int e = 0; e < 4; ++e) { const float gv = acc[ai][0][m][n][e] * r, uv = acc[ai][1][m][n][e] * r; h[n][e] = gv * sigmoidf_(gv) * uv; }
                ST16(H, vo + (ai * 128 + m * 16) * DFF * 2, pack8(h[0], h[1])); }
    }
};

__device__ __forceinline__ void glds16(const void* gsrc, unsigned lds_dst) { unsigned keep;
    asm volatile("s_mov_b32 %0, m0\n\ts_mov_b32 m0, %2\n\ts_nop 0\n\tglobal_load_lds_dwordx4 %1, off\n\ts_mov_b32 m0, %0" : "=&s"(keep) : "v"(gsrc), "s"(lds_dst) : "memory"); }
typedef short v4i16_t __attribute__((ext_vector_type(4)));
__device__ __forceinline__ s16x4 vtr(const LAS unsigned char* p) { return __builtin_bit_cast(s16x4, __builtin_amdgcn_ds_read_tr16_b64_v4i16((LAS v4i16_t*)p)); }
__device__ __forceinline__ float swapmax(float v) { auto rr = __builtin_amdgcn_permlane32_swap(__float_as_uint(v), __float_as_uint(v), false, false); return fmaxf(__uint_as_float(rr[0]), __uint_as_float(rr[1])); }
__device__ __forceinline__ float swapsum(float v) { auto rr = __builtin_amdgcn_permlane32_swap(__float_as_uint(v), __float_as_uint(v), false, false); return __uint_as_float(rr[0]) + __uint_as_float(rr[1]); }

__device__ __forceinline__ void attn_unit(LAS unsigned char* wl, unsigned lds0w, const LAS float* tb, const bf16_t* Qp, const bf16_t* Kp, const bf16_t* Vp, int ntiles, bf16_t* Op, int lane) {
    const int r32 = lane & 31, hi = lane >> 5;
    bf16x8 qf[2][4];
#pragma unroll
    for (int qb = 0; qb < 2; ++qb)
#pragma unroll
        for (int d0 = 0; d0 < 4; ++d0) qf[qb][d0] = *(const bf16x8*)(Qp + (size_t)(32 * qb + r32) * 512 + 16 * d0 + 8 * hi);
    f32x16 o[2][2];
#pragma unroll
    for (int a = 0; a < 2; ++a)
#pragma unroll
        for (int b = 0; b < 2; ++b)
#pragma unroll
            for (int r = 0; r < 16; ++r) o[a][b][r] = 0.f;
    float mrun[2] = {-1e30f, -1e30f}, lrun[2] = {0.f, 0.f};
    const int pos = lane & 7, lrow = lane >> 3, x4 = lane >> 4;
    const unsigned koff0 = lrow * 1024 + ((pos ^ x4) * 16), koff1 = lrow * 1024 + ((pos ^ x4 ^ 4) * 16), voff = lrow * 1024 + ((pos ^ ((x4 & 1) << 2)) * 16);
    const unsigned kdst = lds0w, vdst = lds0w + 8192;
#define DMA_K(t) do { const char* _s = (const char*)Kp + (size_t)(t) * 65536; _Pragma("unroll") for (int _i = 0; _i < 8; ++_i) glds16(_s + _i * 8192 + ((_i & 1) ? koff1 : koff0), (unsigned)__builtin_amdgcn_readfirstlane(kdst + _i * 1024)); } while (0)
#define DMA_V(t) do { const char* _s = (const char*)Vp + (size_t)(t) * 65536; _Pragma("unroll") for (int _i = 0; _i < 8; ++_i) glds16(_s + _i * 8192 + voff, (unsigned)__builtin_amdgcn_readfirstlane(vdst + _i * 1024)); } while (0)
    const int xk = (r32 >> 1) & 7;
    const LAS unsigned char* kb[4];
#pragma unroll
    for (int d0 = 0; d0 < 4; ++d0) kb[d0] = wl + r32 * 128 + (((2 * d0 + hi) ^ xk) * 16);
    const int vl = (4 * hi + ((lane & 15) >> 2)) * 128 + (2 * ((lane >> 4) & 1) + ((lane & 3) >> 1)) * 16 + 8 * (lane & 1);
    const LAS unsigned char* vb[2];
    vb[0] = wl + 8192 + vl + 64 * (0 ^ ((lane >> 3) & 1)); vb[1] = wl + 8192 + vl + 64 * (1 ^ ((lane >> 3) & 1));
    DMA_K(0); DMA_V(0);
    for (int t = 0; t < ntiles; ++t) {
        const int dc = ntiles - 1 - t; const bool more = (t + 1 < ntiles);
        f32x16 s[2][2];
        if (dc <= 2) {
            const LAS float* bp = tb + (128 + 64 * dc + r32 - 4 * hi - 59);
#pragma unroll
            for (int kvb = 0; kvb < 2; ++kvb)
#pragma unroll
                for (int qb = 0; qb < 2; ++qb)
#pragma unroll
                    for (int r = 0; r < 16; ++r) s[kvb][qb][r] = bp[59 + 32 * (qb - kvb) - ((r & 3) + 8 * (r >> 2))];
        } else {
            const float c = tb[256];
#pragma unroll
            for (int kvb = 0; kvb < 2; ++kvb)
#pragma unroll
                for (int qb = 0; qb < 2; ++qb)
#pragma unroll
                    for (int r = 0; r < 16; ++r) s[kvb][qb][r] = c;
        }
        asm volatile("s_waitcnt vmcnt(8)" ::: "memory");
#pragma unroll
        for (int kvb = 0; kvb < 2; ++kvb)
#pragma unroll
            for (int d0 = 0; d0 < 4; ++d0) { const bf16x8 kf = *(const LAS bf16x8*)(kb[d0] + kvb * 4096);
                s[kvb][0] = __builtin_amdgcn_mfma_f32_32x32x16_bf16(kf, qf[0][d0], s[kvb][0], 0, 0, 0);
                s[kvb][1] = __builtin_amdgcn_mfma_f32_32x32x16_bf16(kf, qf[1][d0], s[kvb][1], 0, 0, 0); }
        asm volatile("s_waitcnt lgkmcnt(0)" ::: "memory");
        if (more) DMA_K(t + 1);
        bf16x8 pf[2][4];
#pragma unroll
        for (int qb = 0; qb < 2; ++qb) {
            float mx = s[0][qb][0];
#pragma unroll
            for (int r = 1; r < 16; ++r) mx = fmaxf(mx, s[0][qb][r]);
#pragma unroll
            for (int r = 0; r < 16; ++r) mx = fmaxf(mx, s[1][qb][r]);
            mx = swapmax(mx);
            const float mn = fmaxf(mrun[qb], mx), alpha = __builtin_amdgcn_exp2f(mrun[qb] - mn); mrun[qb] = mn;
            float ls = 0.f;
#pragma unroll
            for (int kvb = 0; kvb < 2; ++kvb)
#pragma unroll
                for (int r = 0; r < 16; ++r) { const float p = __builtin_amdgcn_exp2f(s[kvb][qb][r] - mn); s[kvb][qb][r] = p; ls += p; }
            lrun[qb] = lrun[qb] * alpha + ls;
#pragma unroll
            for (int db = 0; db < 2; ++db)
#pragma unroll
                for (int r = 0; r < 16; ++r) o[db][qb][r] *= alpha;
#pragma unroll
            for (int si = 0; si < 4; ++si) { const int kvb = si >> 1, r0 = 8 * (si & 1); u32x4 w;
                w.x = pg8::cvt_pk_bf16(s[kvb][qb][r0 + 0], s[kvb][qb][r0 + 1]); w.y = pg8::cvt_pk_bf16(s[kvb][qb][r0 + 2], s[kvb][qb][r0 + 3]);
                w.z = pg8::cvt_pk_bf16(s[kvb][qb][r0 + 4], s[kvb][qb][r0 + 5]); w.w = pg8::cvt_pk_bf16(s[kvb][qb][r0 + 6], s[kvb][qb][r0 + 7]);
                pf[qb][si] = __builtin_bit_cast(bf16x8, w); }
        }
        if (more) asm volatile("s_waitcnt vmcnt(8)" ::: "memory"); else asm volatile("s_waitcnt vmcnt(0)" ::: "memory");
#pragma unroll
        for (int si = 0; si < 4; ++si)
#pragma unroll
            for (int db = 0; db < 2; ++db) { const s16x4 lo = vtr(vb[db] + si * 2048), h4 = vtr(vb[db] + si * 2048 + 1024);
                const bf16x8 vf = (bf16x8){lo[0], lo[1], lo[2], lo[3], h4[0], h4[1], h4[2], h4[3]};
                o[db][0] = __builtin_amdgcn_mfma_f32_32x32x16_bf16(vf, pf[0][si], o[db][0], 0, 0, 0);
                o[db][1] = __builtin_amdgcn_mfma_f32_32x32x16_bf16(vf, pf[1][si], o[db][1], 0, 0, 0); }
        asm volatile("s_waitcnt lgkmcnt(0)" ::: "memory");
        if (more) DMA_V(t + 1);
    }
#undef DMA_K
#undef DMA_V
#pragma unroll
    for (int qb = 0; qb < 2; ++qb) { const float inv = 1.0f / swapsum(lrun[qb]); bf16_t* orow = Op + (size_t)(32 * qb + r32) * 1024 + 4 * hi;
#pragma unroll
        for (int db = 0; db < 2; ++db)
#pragma unroll
            for (int g4 = 0; g4 < 4; ++g4) { u32x2 w; w.x = pg8::cvt_pk_bf16(o[db][qb][4 * g4 + 0] * inv, o[db][qb][4 * g4 + 1] * inv); w.y = pg8::cvt_pk_bf16(o[db][qb][4 * g4 + 2] * inv, o[db][qb][4 * g4 + 3] * inv);
                *(u32x2*)(orow + 32 * db + 8 * g4) = w; } }
}

struct Args { const float* in[17]; float* out; unsigned char* ws; int ph_lo, ph_hi; };
static_assert(sizeof(Args) == 19 * 8 + 8, "Args has no padding");

__device__ __forceinline__ unsigned f2bf(float f) { unsigned u = __builtin_bit_cast(unsigned, f); return (u + 0x7fffu + ((u >> 16) & 1u)) >> 16; }
__device__ __forceinline__ unsigned pk2(float lo, float hi) { return f2bf(lo) | (f2bf(hi) << 16); }
__device__ __forceinline__ float wave_sum(float v) {
#pragma unroll
    for (int o = 1; o < 64; o <<= 1) v += __shfl_xor(v, o);
    return v;
}
__device__ __forceinline__ void transpose_item(const float* W, int ldn, int col0, int k0, const float* scale, bf16_t* WT, int K, int nrow0, LAS float* scr, int lane) {
#pragma unroll 8
    for (int i = 0; i < 32; ++i) { const int kk = 2 * i + (lane >> 5); float v = W[(size_t)(k0 + kk) * ldn + col0 + (lane & 31)]; if (scale) v *= scale[k0 + kk]; scr[kk * 33 + (lane & 31)] = v; }
    asm volatile("s_waitcnt lgkmcnt(0)" ::: "memory");
    const int c = lane & 7;
#pragma unroll
    for (int j = 0; j < 4; ++j) { const int n = (lane >> 3) + 8 * j; const LAS float* s = scr + (8 * c) * 33 + n;
        u32x4 o; o.x = pk2(s[0 * 33], s[1 * 33]); o.y = pk2(s[2 * 33], s[3 * 33]); o.z = pk2(s[4 * 33], s[5 * 33]); o.w = pk2(s[6 * 33], s[7 * 33]);
        *(u32x4*)(WT + (size_t)(nrow0 + n) * K + k0 + 8 * c) = o; }
    asm volatile("s_waitcnt lgkmcnt(0)" ::: "memory");
}

#define XB_TMO      128
#define XB_XCNT(j)  (256  + 64 * (j))
#define XB_XSUB(j)  (1280 + 64 * (j))
#define XB_XGEN(j)  (2304 + 64 * (j))
#define XB_TOP      3328
#define XB_TOPGEN   3392
#define XCD_BAR_WORDS 3456
#define XB_SPIN_CAP (1u << 18)
__device__ __forceinline__ unsigned xb_ld(unsigned* p)              { return __hip_atomic_load(p, __ATOMIC_RELAXED, __HIP_MEMORY_SCOPE_AGENT); }
__device__ __forceinline__ unsigned xb_add(unsigned* p, unsigned v) { return __hip_atomic_fetch_add(p, v, __ATOMIC_RELAXED, __HIP_MEMORY_SCOPE_AGENT); }
__device__ __forceinline__ unsigned xb_xcc_id() { return (unsigned)__builtin_amdgcn_s_getreg((3 << 11) | 20) & 0xFu; }
#define XB_SPIN(cond, bar) do { unsigned _sp = 0; while (cond) { __builtin_amdgcn_s_sleep(1); \
    if ((++_sp & 255u) == 0u) { if (xb_ld(&(bar)[XB_TMO])) break; if (_sp > XB_SPIN_CAP) { atomicAdd(&(bar)[XB_TMO], 1u); break; } } } } while (0)
__device__ __forceinline__ void xcd_barrier_complete(unsigned* bar, unsigned x, unsigned& nloc, unsigned& nx) {
    const unsigned G = gridDim.x * gridDim.y * gridDim.z;
    unsigned sum, cnt, mine, sp = 0u;
    for (;;) {
        sum = 0u; cnt = 0u; mine = 0u;
#pragma unroll
        for (unsigned j = 0; j < 16; ++j) { const unsigned c = xb_ld(&bar[XB_XCNT(j)]); sum += c; cnt += (c > 0u) ? 1u : 0u; mine = (j == x) ? c : mine; }
        if (sum == G) break;
        __builtin_amdgcn_s_sleep(1);
        if ((++sp & 255u) == 0u) { if (xb_ld(&bar[XB_TMO])) break; if (sp > XB_SPIN_CAP) { atomicAdd(&bar[XB_TMO], 1u); break; } }
    }
    nloc = mine > 0u ? mine : 1u; nx = cnt > 0u ? cnt : 1u;
}
__device__ __forceinline__ void xcd_barrier(unsigned* bar, volatile LAS unsigned* st) {
    asm volatile("s_waitcnt vmcnt(0)" ::: "memory");
    __syncthreads();
    if (threadIdx.x == 0) {
        __builtin_amdgcn_s_waitcnt(0);
        const unsigned x = xb_xcc_id();
        unsigned nloc = st[0], nx = st[1];
        if (nloc == 0u) { xcd_barrier_complete(bar, x, nloc, nx); st[0] = nloc; st[1] = nx; }
        const unsigned old = xb_add(&bar[XB_XSUB(x)], 1u);
        const unsigned gen = old / nloc;
        if (old + 1u == (gen + 1u) * nloc) {
            __builtin_amdgcn_fence(__ATOMIC_RELEASE, "agent");
            asm volatile("s_waitcnt vmcnt(0)" ::: "memory");
            const unsigned og = xb_add(&bar[XB_TOP], 1u);
            const unsigned tg = og / nx;
            if (og + 1u == (tg + 1u) * nx) xb_add(&bar[XB_TOPGEN], 1u);
            else XB_SPIN(xb_ld(&bar[XB_TOPGEN]) == tg, bar);
            __builtin_amdgcn_fence(__ATOMIC_ACQUIRE, "agent");
            xb_add(&bar[XB_XGEN(x)], 1u);
            asm volatile("s_waitcnt vmcnt(0)" ::: "memory");
        } else {
            XB_SPIN(xb_ld(&bar[XB_XGEN(x)]) == gen, bar);
            __builtin_amdgcn_fence(__ATOMIC_ACQUIRE, "agent");
            asm volatile("s_waitcnt vmcnt(0)" ::: "memory");
        }
    }
    __syncthreads();
}

typedef const char __attribute__((address_space(4)))* kptr_t;
__device__ __forceinline__ const void* karg(int k) { kptr_t ka = (kptr_t)__builtin_amdgcn_kernarg_segment_ptr(); asm volatile("" : "+s"(ka)); return *(const void* const __attribute__((address_space(4)))*)(ka + 8 * k); }
#define KIN(k) ((const float*)karg(k))
#define KOUT() ((float*)karg(17))
#define KWS() ((unsigned char*)karg(18))

__global__ void __launch_bounds__(512, 2) fwd_kernel(Args args) {
    extern __shared__ __attribute__((aligned(16))) unsigned char lds_raw[];
    LAS unsigned char* lds = (LAS unsigned char*)lds_raw;
    { volatile LAS unsigned* st0 = (volatile LAS unsigned*)(lds + MISC_OFF + 32); if (threadIdx.x < 2) st0[threadIdx.x] = 0u; __syncthreads();
      if (threadIdx.x == 0) (void)xb_add((unsigned*)(KWS() + CTL_BAR) + XB_XCNT(xb_xcc_id()), 1u); }
    const int lo = args.ph_lo, hi = args.ph_hi;
#ifndef PH_MASK
#define PH_MASK 0x1ff
#endif
#define IN(k) (((PH_MASK >> (k)) & 1) && lo <= (k) && (k) < hi)
#ifndef REPEAT_MASK
#define REPEAT_MASK 0
#endif
#define REP(k) for (int rep_ = 0; rep_ < 1 + ((REPEAT_MASK >> (k)) & 1); ++rep_)
#define GRID_BAR() xcd_barrier((unsigned*)(KWS() + CTL_BAR), (volatile LAS unsigned*)(lds + MISC_OFF + 32))
#define SEAM(k) do { if (IN(k) && IN((k) + 1)) GRID_BAR(); } while (0)
#define GEOM() int tid_ = threadIdx.x; asm volatile("" : "+v"(tid_)); const int tid = tid_, lane = tid & 63, wave = __builtin_amdgcn_readfirstlane(tid >> 6); const int G = gridDim.x, bx = blockIdx.x; \
    const int vcu = (G % 8 == 0) ? (bx % 8) * (G / 8) + bx / 8 : bx; (void)lane; (void)wave; (void)vcu; (void)tid

    if (IN(0)) REP(0) {
        GEOM();
        unsigned char* ws = KWS();
        LAS float* scr = (LAS float*)(lds + wave * 16384);
        const int gw = vcu * 8 + wave, NGW = G * 8;
        constexpr int I_IN = (D / 64) * (NIN / 32), I_CO = (CD / 64) * (D / 32), I_AO = I_CO, I_OUT = (D / 64) * (D / 32), I_13 = (D / 64) * (NFF / 32), I_2 = (DFF / 64) * (D / 32);
        constexpr int NITEMS = I_IN + I_CO + I_AO + I_OUT + I_13 + I_2;
        for (int it = gw; it < NITEMS; it += NGW) {
            int r = it;
            if (r < I_IN) { const int nb = r % (NIN / 32), kb = r / (NIN / 32); const int tile = nb >> 3, w = nb & 7; int col0 = 32 * nb;
                if (tile >= 2 && tile < 6) col0 = (w < 4) ? (512 + 128 * (tile - 2) + 32 * w) : (1024 + 128 * (tile - 2) + 32 * (w - 4));
                transpose_item(KIN(6), NIN, col0, 64 * kb, nullptr, (bf16_t*)(ws + WS_WIN), D, 32 * nb, scr, lane); continue; } r -= I_IN;
            if (r < I_CO) { const int nb = r % (D / 32), kb = r / (D / 32); transpose_item(KIN(8), D, 32 * nb, 64 * kb, nullptr, (bf16_t*)(ws + WS_WCO), CD, 32 * nb, scr, lane); continue; } r -= I_CO;
            if (r < I_AO) { const int nb = r % (D / 32), kb = r / (D / 32); transpose_item(KIN(10), D, 32 * nb, 64 * kb, nullptr, (bf16_t*)(ws + WS_WAO), AD, 32 * nb, scr, lane); continue; } r -= I_AO;
            if (r < I_OUT) { const int nb = r % (D / 32), kb = r / (D / 32); transpose_item(KIN(11), D, 32 * nb, 64 * kb, nullptr, (bf16_t*)(ws + WS_WOUT), D, 32 * nb, scr, lane); continue; } r -= I_OUT;
            if (r < I_13) { const int nb = r % (NFF / 32), kb = r / (NFF / 32); const int tile = nb >> 3, w = nb & 7;
                const float* src = (w < 4) ? KIN(13) : KIN(14); const int col0 = 128 * tile + 32 * (w & 3);
                transpose_item(src, DFF, col0, 64 * kb, KIN(12), (bf16_t*)(ws + WS_W13), D, 32 * nb, scr, lane); continue; } r -= I_13;
            { const int nb = r % (D / 32), kb = r / (D / 32); transpose_item(KIN(15), D, 32 * nb, 64 * kb, nullptr, (bf16_t*)(ws + WS_W2), DFF, 32 * nb, scr, lane); }
        }
        {
            const float* x_prompt = KIN(0); const float* x_sample = KIN(1); const float* g_mix = KIN(5); bf16_t* R1 = (bf16_t*)(ws + WS_R1);
            for (int m = gw; m < M; m += NGW) {
                const float* xrow = (m < MP) ? x_prompt + (size_t)m * D : x_sample + (size_t)(m - MP) * D;
                const f32x4* xr = (const f32x4*)xrow + lane; const f32x4* gr = (const f32x4*)g_mix + lane;
                f32x4 v[4]; float s = 0.f;
#pragma unroll
                for (int j = 0; j < 4; ++j) { v[j] = xr[64 * j]; s += (v[j].x * v[j].x + v[j].y * v[j].y) + (v[j].z * v[j].z + v[j].w * v[j].w); }
                const float rstd = 1.0f / sqrtf(wave_sum(s) * (1.0f / D) + EPS);
                u32x2* o8 = (u32x2*)(R1 + (size_t)m * D) + lane;
#pragma unroll
                for (int j = 0; j < 4; ++j) { const f32x4 gg = gr[64 * j]; u32x2 w; w.x = pk2(v[j].x * rstd * gg.x, v[j].y * rstd * gg.y); w.y = pk2(v[j].z * rstd * gg.z, v[j].w * rstd * gg.w); o8[64 * j] = w; }
            }
        }
        {
            const float* cache_k = KIN(3); const float* cache_v = KIN(4); float* out = KOUT();
            for (int it = gw; it < 2 * NB * KVR; it += NGW) {
                const int isV = it >= NB * KVR, rr = isV ? it - NB * KVR : it, b = rr / KVR, r = rr % KVR;
                const float* src = (isV ? cache_v : cache_k) + (size_t)rr * 512 + lane * 8;
                const f32x4 a = *(const f32x4*)src, c = *(const f32x4*)(src + 4);
                u32x4 w; w.x = pk2(a.x, a.y); w.y = pk2(a.z, a.w); w.z = pk2(c.x, c.y); w.w = pk2(c.z, c.w);
                *(u32x4*)((bf16_t*)(ws + (isV ? WS_VS : WS_KS)) + (size_t)(b * KSR + r) * 512 + lane * 8) = w;
                if (r >= DSEQ) { float* d = out + (isV ? OFF_VS : OFF_KS) + (size_t)(b * KVR + r - DSEQ) * 512 + lane * 8; *(f32x4*)d = a; *(f32x4*)(d + 4) = c; }
            }
        }
    }
    SEAM(0);

    if (IN(1)) REP(1) {
        unsigned char* ws = KWS();
        pg8::Gemm g{(const bf16_t*)(ws + WS_R1), (const bf16_t*)(ws + WS_WIN), M, NIN, D, D, D}; pg8::StaticOrder S; S.init(M, NIN, gridDim.x, blockIdx.x);
        EpiInProj E{ws, KOUT()};
        pg8::gemm_phase(lds, g, S, E);
    }
    SEAM(1);

    if (IN(2)) REP(2) {
        GEOM();
        unsigned char* ws = KWS();
        LAS float* tbl = (LAS float*)(lds + TBL_OFF);
        { const float* rel_bias = KIN(9);
          for (int i = tid; i < NH * TBL_STRIDE; i += 512) { const int h = i / TBL_STRIDE, j = i % TBL_STRIDE; tbl[i] = rel_bias[h * 257 + (j < 256 ? j : 256)] * LOG2E; } }
        __syncthreads();
        volatile LAS int* misc = (volatile LAS int*)(lds + MISC_OFF);
        const unsigned lds0 = (unsigned)(uintptr_t)lds_raw;
        constexpr int NUNITS = NB * (SEQ / 64) + NB;
        bf16_t* R2 = (bf16_t*)(ws + WS_R2);
        for (;;) {
            __syncthreads();
            if (tid == 0) misc[0] = (int)atomicAdd((unsigned*)(ws + WS_CTL) + 64 + 64 * rep_, 1u);
            __syncthreads();
            const int ui = misc[0];
            if (ui >= NUNITS) break;
            int b, c; bool smp = false;
            if (ui < 768) { const int grp = ui >> 8, w = ui & 255; b = w >> 3; c = 8 + 8 * grp + (w & 7); }
            else if (ui < 800) { smp = true; b = ui - 768; c = 0; }
            else { const int w = ui - 800; c = 7 - (w >> 5); b = w & 31; }
            const size_t row0 = smp ? (size_t)MP + (size_t)b * DSEQ : (size_t)b * SEQ + (size_t)c * 64;
            {
                const float* w_conv = KIN(7); const bf16_t* UB = (const bf16_t*)(ws + WS_U); const bf16_t* CB = (const bf16_t*)(ws + WS_CB);
                const int cb8 = (tid & 63) * 8, rg = tid >> 6;
                float w0[8], w1[8], w2[8];
#pragma unroll
                for (int e = 0; e < 8; ++e) { w0[e] = w_conv[cb8 + e]; w1[e] = w_conv[CD + cb8 + e]; w2[e] = w_conv[2 * CD + cb8 + e]; }
                f32x4 pa0, pa1, pb0, pb1;
                const size_t r0 = row0 + 8 * rg;
                if (rg == 0 && smp) { const float* sp = KIN(2) + (size_t)b * 2 * CD + cb8; pa0 = *(const f32x4*)sp; pa1 = *(const f32x4*)(sp + 4); pb0 = *(const f32x4*)(sp + CD); pb1 = *(const f32x4*)(sp + CD + 4); }
                else if (rg == 0 && c == 0) { pa0 = pa1 = pb0 = pb1 = (f32x4){0.f, 0.f, 0.f, 0.f}; }
                else { unpack8(*(const u32x4*)(UB + (r0 - 2) * CD + cb8), pa0, pa1); unpack8(*(const u32x4*)(UB + (r0 - 1) * CD + cb8), pb0, pb1); }
#pragma unroll
                for (int i = 0; i < 8; ++i) {
                    f32x4 c0, c1, e0, e1; unpack8(*(const u32x4*)(UB + (r0 + i) * CD + cb8), c0, c1); unpack8(*(const u32x4*)(CB + (r0 + i) * CD + cb8), e0, e1);
                    f32x4 y0, y1;
#pragma unroll
                    for (int e = 0; e < 4; ++e) { y0[e] = e0[e] * (w0[e] * pa0[e] + w1[e] * pb0[e] + w2[e] * c0[e]); y1[e] = e1[e] * (w0[4 + e] * pa1[e] + w1[4 + e] * pb1[e] + w2[4 + e] * c1[e]); }
                    *(u32x4*)(R2 + (r0 + i) * D + cb8) = pack8(y0, y1);
                    pa0 = pb0; pa1 = pb1; pb0 = c0; pb1 = c1;
                }
            }
            EPI_FENCE();
            {
                const int h = wave; int ntiles; const bf16_t *Kp, *Vp;
                if (smp) { ntiles = 9; Kp = (const bf16_t*)(ws + WS_KS) + (size_t)b * KSR * 512 + h * 64; Vp = (const bf16_t*)(ws + WS_VS) + (size_t)b * KSR * 512 + h * 64; }
                else { const int c0 = c > 8 ? c - 8 : 0; ntiles = c - c0 + 1; const size_t kr = (size_t)b * SEQ + (size_t)c0 * 64; Kp = (const bf16_t*)(ws + WS_KB) + kr * 512 + h * 64; Vp = (const bf16_t*)(ws + WS_VB) + kr * 512 + h * 64; }
                attn_unit(lds + wave * 16384, lds0 + wave * 16384, tbl + h * TBL_STRIDE, (const bf16_t*)(ws + WS_Q) + row0 * 512 + h * 64, Kp, Vp, ntiles, R2 + row0 * D + 512 + h * 64, lane);
            }
        }
    }
    SEAM(2);

    if (IN(3)) REP(3) {
        unsigned char* ws = KWS();
        pg8::Gemm g{(const bf16_t*)(ws + WS_R2), (const bf16_t*)(ws + WS_WCO), M, D, CD, D, CD}; pg8::StaticOrder S; S.init(M, D, gridDim.x, blockIdx.x);
        EpiGate<false> E{ws};
        pg8::gemm_phase(lds, g, S, E);
    }
    SEAM(3);
    if (IN(4)) {
        unsigned char* ws = KWS();
        pg8::Gemm g{(const bf16_t*)(ws + WS_R2) + 512, (const bf16_t*)(ws + WS_WAO), M, D, AD, D, AD}; pg8::StaticOrder S; S.init(M, D, gridDim.x, blockIdx.x);
        EpiGate<true> E{ws};
        pg8::gemm_phase(lds, g, S, E);
    }
    SEAM(4);
    if (IN(5)) {
        unsigned char* ws = KWS();
        pg8::Gemm g{(const bf16_t*)(ws + WS_R1), (const bf16_t*)(ws + WS_WOUT), M, D, D, D, D}; pg8::StaticOrder S; S.init(M, D, gridDim.x, blockIdx.x);
        EpiResid<true> E{KIN(0), KIN(1), ws, nullptr};
        pg8::gemm_phase(lds, g, S, E);
    }
    SEAM(5);
    if (IN(6)) REP(6) {
        unsigned char* ws = KWS();
        pg8::Gemm g{(const bf16_t*)(ws + WS_R2), (const bf16_t*)(ws + WS_W13), M, NFF, D, D, D}; pg8::StaticOrder S; S.init(M, NFF, gridDim.x, blockIdx.x);
        EpiSwiGLU E{ws};
        pg8::gemm_phase(lds, g, S, E);
    }
    SEAM(6);
    if (IN(7)) {
        unsigned char* ws = KWS();
        pg8::Gemm g{(const bf16_t*)(ws + WS_H), (const bf16_t*)(ws + WS_W2), M, D, DFF, DFF, DFF}; pg8::StaticOrder S; S.init(M, D, gridDim.x, blockIdx.x);
        EpiResid<false> E{nullptr, nullptr, ws, KOUT()};
        pg8::gemm_phase(lds, g, S, E);
    }
    SEAM(7);
    if (IN(8)) {
        GEOM();
        const float* SS2 = (const float*)(KWS() + CTL_SS2); float* out = KOUT();
        const int gw = vcu * 8 + wave, NGW = G * 8;
        const f32x4* gr = (const f32x4*)KIN(16) + lane;
        f32x4 gg[4];
#pragma unroll
        for (int j = 0; j < 4; ++j) gg[j] = gr[64 * j];
        for (int m = gw; m < M; m += NGW) {
            f32x4* yr = (f32x4*)(out + OFF_Y + (size_t)m * D) + lane;
            const float rs = 1.0f / sqrtf(SS2[m] * (1.0f / D) + EPS);
#pragma unroll
            for (int j = 0; j < 4; ++j) { f32x4 v = yr[64 * j]; v = v * rs * gg[j]; yr[64 * j] = v; }
        }
    }
#ifdef DBG_DUMP_OFF
    {
        GRID_BAR();
        GEOM();
        const bf16_t* src = (const bf16_t*)(KWS() + (size_t)DBG_DUMP_OFF); float* out = KOUT();
        const int gw = vcu * 8 + wave, NGW = G * 8;
        for (int m = gw; m < M; m += NGW) {
#pragma unroll
            for (int j = 0; j < 2; ++j) { f32x4 a, b; unpack8(*(const u32x4*)(src + (size_t)m * D + j * 512 + lane * 8), a, b); float* d = out + (size_t)m * D + j * 512 + lane * 8; *(f32x4*)d = a; *(f32x4*)(d + 4) = b; }
        }
    }
#endif
#undef IN
#undef SEAM
}

#ifndef N_LAUNCHES
#define N_LAUNCHES 1
#endif
constexpr int NPHASE = 9;
extern "C" void kernel_launch(void* const* d_in, const int* in_sizes, int n_in, void* d_out, int out_size, void* d_ws, size_t ws_size, hipStream_t stream) {
    static int grid = 0;
    if (grid == 0) {
        if (n_in != 17 || ws_size < WS_END) { fprintf(stderr, "kernel_launch: unexpected n_in %d / ws %zu\n", n_in, ws_size); grid = -1; return; }
        int dev = 0, cus = 0, per_cu = 0;
        (void)hipGetDevice(&dev); (void)hipDeviceGetAttribute(&cus, hipDeviceAttributeMultiprocessorCount, dev);
        if (hipFuncSetAttribute((const void*)fwd_kernel, hipFuncAttributeMaxDynamicSharedMemorySize, LDS_BYTES) != hipSuccess) { fprintf(stderr, "kernel_launch: hipFuncSetAttribute failed\n"); grid = -1; return; }
        if (hipOccupancyMaxActiveBlocksPerMultiprocessor(&per_cu, (const void*)fwd_kernel, 512, LDS_BYTES) != hipSuccess || per_cu < 1) { fprintf(stderr, "kernel_launch: occupancy query says %d\n", per_cu); per_cu = 1; }
        (void)hipGetLastError();
        grid = cus;
    }
    if (grid < 0) return;
    (void)hipMemsetAsync((char*)d_ws + WS_CTL, 0, CTL_BYTES, stream);
    Args a{};
    for (int i = 0; i < 17; ++i) a.in[i] = (const float*)d_in[i];
    a.out = (float*)d_out; a.ws = (unsigned char*)d_ws;
#if N_LAUNCHES == 1
#ifndef PH_HI
#define PH_HI NPHASE
#endif
    a.ph_lo = 0; a.ph_hi = PH_HI;
    hipLaunchKernelGGL(fwd_kernel, dim3(grid), dim3(512), LDS_BYTES, stream, a);
#else
    for (int p = 0; p < NPHASE; ++p) { a.ph_lo = p; a.ph_hi = p + 1; hipLaunchKernelGGL(fwd_kernel, dim3(grid), dim3(512), LDS_BYTES, stream, a); }
#endif
}
```

```cpp
#include <hip/hip_runtime.h>
#include <cstdio>
#include <cstdint>

#define LAS __attribute__((address_space(3)))
typedef unsigned short bf16_t;
typedef short bf16x8 __attribute__((ext_vector_type(8)));
typedef short s16x4 __attribute__((ext_vector_type(4)));
typedef float f32x4 __attribute__((ext_vector_type(4)));
typedef float f32x16 __attribute__((ext_vector_type(16)));
typedef unsigned u32x4 __attribute__((ext_vector_type(4)));
typedef unsigned u32x2 __attribute__((ext_vector_type(2)));

constexpr int D = 1024, NB = 32, SEQ = 2048, DSEQ = 64, MP = NB * SEQ, MS = NB * DSEQ, M = MP + MS;
constexpr int CD = 512, AD = 512, NH = 8, HD = 64, DFF = 2816, NIN = 5120, NFF = 2 * DFF, KVR = 512, KSR = KVR + DSEQ;
constexpr float EPS = 1e-6f;
constexpr float LOG2E = 1.4426950408889634f;
constexpr float C2 = 0.125f * LOG2E;
constexpr size_t OFF_Y = 0, OFF_CONVP = (size_t)M * D, OFF_KP = OFF_CONVP + (size_t)NB * 2 * CD, OFF_VP = OFF_KP + (size_t)NB * KVR * AD,
                 OFF_CONVS = OFF_VP + (size_t)NB * KVR * AD, OFF_KS = OFF_CONVS + (size_t)NB * 2 * CD, OFF_VS = OFF_KS + (size_t)NB * KVR * AD;
constexpr size_t MiB = 1u << 20;
constexpr size_t WS_CTL = 0, CTL_BYTES = 1 * MiB;
constexpr size_t CTL_SS1 = 4096, CTL_SS2 = CTL_SS1 + (size_t)M * 4;
constexpr size_t CTL_BAR = 614400;
static_assert(CTL_SS2 + (size_t)M * 4 <= CTL_BAR && CTL_BAR + 3456 * 4 <= CTL_BYTES, "ctl");
constexpr size_t WS_WIN = 2 * MiB, WS_WCO = 12 * MiB, WS_WAO = 13 * MiB, WS_WOUT = 14 * MiB, WS_W13 = 16 * MiB, WS_W2 = 27 * MiB;
constexpr size_t WS_R2 = 34 * MiB, WS_R1 = 166 * MiB;
constexpr size_t WS_CB = 298 * MiB, WS_U = 364 * MiB, WS_Q = 430 * MiB, WS_KB = 496 * MiB, WS_VB = 562 * MiB;
constexpr size_t WS_RAT = 628 * MiB, WS_SGB = 760 * MiB;
constexpr size_t WS_KS = 892 * MiB, WS_VS = 910 * MiB;
constexpr size_t WS_H = 166 * MiB;
constexpr size_t WS_X1 = 628 * MiB;
constexpr size_t WS_END = 928 * MiB;
static_assert(WS_H + (size_t)M * DFF * 2 <= WS_X1 && WS_X1 + (size_t)M * D * 4 <= WS_KS, "ws map");

constexpr int RING_BYTES = 131072, TBL_OFF = RING_BYTES, TBL_STRIDE = 320, MISC_OFF = TBL_OFF + NH * TBL_STRIDE * 4, LDS_BYTES = 147456;
static_assert(MISC_OFF + 256 <= LDS_BYTES, "lds");

namespace pg8 {
constexpr int BM = 256, BK = 64, HALF = 128, HTB = HALF * BK * 2, NXCD = 8, WGM = 8;
__host__ __device__ __forceinline__ int lds_byte(int r, int c) { const int st = (r >> 4) * 2 + (c >> 5), rr = r & 15, cc = c & 31, ob = rr * 64 + cc * 2; return st * 1024 + (ob ^ (((ob >> 9) & 1) << 5)); }
__host__ __device__ __forceinline__ void stage_rc(int b, int& R, int& C) { const int st = b / 1024, sb = b % 1024, swz = sb ^ (((sb >> 9) & 1) << 5); R = (st >> 1) * 16 + swz / 64; C = (st & 1) * 32 + (swz % 64) / 2; }
__host__ __device__ __forceinline__ int perm32(int rho) { const int n = rho >> 4, i = rho & 15; return 8 * (i >> 2) + 4 * n + (i & 3); }

struct Unit { int pm, pn; };
struct Gemm { const bf16_t* A; const bf16_t* Bt; int M, N, K, lda, ldb; const bf16_t* A2; const bf16_t* Bt2; };

struct StaticOrder {
    int nM, nN, nwg, G, c;
    __host__ __device__ void init(int M_, int N_, int G_, int c_) { nM = M_ / BM; nN = N_ / BM; nwg = nM * nN; G = G_; c = c_; }
    __host__ __device__ bool next(int i, Unit& u) const {
        const long L = (long)i * G + c; if (L >= nwg) return false;
        int wgid = (int)L; { const int q = nwg / NXCD, r = nwg % NXCD, xcd = wgid % NXCD, off = wgid / NXCD; wgid = (xcd < r ? xcd * (q + 1) : r * (q + 1) + (xcd - r) * q) + off; }
        const int nig = WGM * nN, gid = wgid / nig, fm = gid * WGM, gsz = (nM - fm) < WGM ? (nM - fm) : WGM;
        u.pm = fm + ((wgid % nig) % gsz); u.pn = (wgid % nig) / gsz; return true;
    }
};

typedef float f32x2_t __attribute__((ext_vector_type(2))); typedef __bf16 bf16x2_t __attribute__((ext_vector_type(2)));
__device__ __forceinline__ unsigned cvt_pk_bf16(float lo, float hi) { f32x2_t v = {lo, hi}; bf16x2_t b = __builtin_convertvector(v, bf16x2_t); return __builtin_bit_cast(unsigned, b); }
__device__ __forceinline__ u32x4 pack8(f32x4 v0, f32x4 v1) { u32x4 w; w.x = cvt_pk_bf16(v0[0], v0[1]); w.y = cvt_pk_bf16(v0[2], v0[3]); w.z = cvt_pk_bf16(v1[0], v1[1]); w.w = cvt_pk_bf16(v1[2], v1[3]); return w; }
__device__ __forceinline__ void unpack8(u32x4 w, f32x4& v0, f32x4& v1) {
    v0[0] = __uint_as_float(w.x << 16); v0[1] = __uint_as_float(w.x & 0xffff0000u); v0[2] = __uint_as_float(w.y << 16); v0[3] = __uint_as_float(w.y & 0xffff0000u);
    v1[0] = __uint_as_float(w.z << 16); v1[1] = __uint_as_float(w.z & 0xffff0000u); v1[2] = __uint_as_float(w.w << 16); v1[3] = __uint_as_float(w.w & 0xffff0000u);
}

template <class Epi, bool DUAL = false>
__device__ __forceinline__ void gemm_phase(LAS unsigned char* lds, const Gemm g, const StaticOrder& S, const Epi& E) {
    int tid_ = threadIdx.x; asm volatile("" : "+v"(tid_));
    const int tid = tid_, wid = __builtin_amdgcn_readfirstlane(tid >> 6), lane = tid & 63, wr = wid >> 2, wc = wid & 3, fr = lane & 15, fq = lane >> 4;
    const int K = g.K, nt = K / BK;
    unsigned voffA[2], voffB[2];
#pragma unroll
    for (int i = 0; i < 2; ++i) { int R, C; stage_rc(tid * 16 + i * 8192, R, C); const int Rb = (R & ~31) + perm32(R & 31);
        voffA[i] = (unsigned)(R * g.lda + C) * 2u; voffB[i] = (unsigned)(Rb * g.ldb + C) * 2u; }
    const size_t kstep = (size_t)(BK * 2);
    const size_t hstepA = (size_t)HALF * g.lda * 2, hstepB = (size_t)HALF * g.ldb * 2;
    const size_t tstepA = 2 * hstepA, tstepB = 2 * hstepB;
    const unsigned ldsw = (unsigned)wid * 1024u;
    const int aoff = lds_byte(wr * 64 + fr, fq * 8), boff = lds_byte(wc * 32 + fr, fq * 8);
#define PG8_SA(b, h) (((b) * 2 + (h)) * HTB)
#define PG8_SB(b, h) ((4 + (b) * 2 + (h)) * HTB)
#define PG8_STAGE(bufoff, gbase, voff) do { _Pragma("unroll") for (int _i = 0; _i < 2; ++_i) \
        __builtin_amdgcn_global_load_lds((const unsigned*)((const char*)(gbase) + (voff)[_i]), (LAS unsigned*)(lds + (bufoff) + ldsw + _i * 8192), 16, 0, 0); } while (0)
#define PG8_LDA(dst, b, h) do { _Pragma("unroll") for (int m = 0; m < 4; ++m) _Pragma("unroll") for (int k = 0; k < 2; ++k) dst[m][k] = *(const LAS bf16x8*)(lds + PG8_SA(b, h) + aoff + m * 2048 + k * 1024); } while (0)
#define PG8_LDB(dst, b, h) do { _Pragma("unroll") for (int n = 0; n < 2; ++n) _Pragma("unroll") for (int k = 0; k < 2; ++k) dst[n][k] = *(const LAS bf16x8*)(lds + PG8_SB(b, h) + boff + n * 2048 + k * 1024); } while (0)
#define PG8_MMA(ai, bj, At, Bt) do { __builtin_amdgcn_s_setprio(1); _Pragma("unroll") for (int m = 0; m < 4; ++m) _Pragma("unroll") for (int n = 0; n < 2; ++n) _Pragma("unroll") for (int k = 0; k < 2; ++k) \
        acc[ai][bj][m][n] = __builtin_amdgcn_mfma_f32_16x16x32_bf16(Bt[n][k], At[m][k], acc[ai][bj][m][n], 0, 0, 0); __builtin_amdgcn_s_setprio(0); } while (0)
#define PG8_WAIT_V(n) asm volatile("s_waitcnt vmcnt(" #n ")" ::: "memory")
#define PG8_WAIT_L(n) asm volatile("s_waitcnt lgkmcnt(" #n ")" ::: "memory")
#define PG8_BAR __builtin_amdgcn_s_barrier()
#define PG8_SCHED __builtin_amdgcn_sched_barrier(0)
    Unit cur, nxt; int ui = 0, part = 0;
    if (!S.next(0, cur)) return;
    f32x4 acc[2][2][4][2];
#pragma unroll
    for (int a = 0; a < 2; ++a)
#pragma unroll
        for (int b = 0; b < 2; ++b)
#pragma unroll
            for (int m = 0; m < 4; ++m)
#pragma unroll
                for (int n = 0; n < 2; ++n) acc[a][b][m][n] = (f32x4){0.f, 0.f, 0.f, 0.f};
    bf16x8 At[4][2], B0[2][2], B1[2][2];
    const char* cA = (const char*)g.A + (size_t)cur.pm * tstepA; const char* cB = (const char*)g.Bt + (size_t)cur.pn * tstepB;
    PG8_STAGE(PG8_SB(0, 0), cB, voffB); PG8_STAGE(PG8_SB(0, 1), cB + hstepB, voffB); PG8_STAGE(PG8_SA(0, 0), cA, voffA); PG8_STAGE(PG8_SA(0, 1), cA + hstepA, voffA);
    if (wr == 1) PG8_BAR;
    PG8_WAIT_V(2); PG8_BAR;
    PG8_STAGE(PG8_SB(1, 0), cB + kstep, voffB); PG8_STAGE(PG8_SA(1, 0), cA + kstep, voffA); PG8_STAGE(PG8_SB(1, 1), cB + hstepB + kstep, voffB);
    PG8_WAIT_V(6); PG8_BAR;
    for (;;) {
        bool has_next; int npart = 0;
        if (DUAL && part == 0) { has_next = true; nxt = cur; npart = 1; } else has_next = S.next(ui + 1, nxt);
        const char* nA = has_next ? (const char*)((DUAL && npart) ? g.A2 : g.A) + (size_t)nxt.pm * tstepA : cA; const char* nB = has_next ? (const char*)((DUAL && npart) ? g.Bt2 : g.Bt) + (size_t)nxt.pn * tstepB : cB;
        for (int t = 0; t < nt; t += 2) {
            const bool last = (t == nt - 2);
            const char* a1 = cA + (size_t)(t + 1) * kstep;
            const char* a2 = last ? nA : cA + (size_t)(t + 2) * kstep; const char* b2 = last ? nB : cB + (size_t)(t + 2) * kstep;
            const char* a3 = a2 + kstep; const char* b3 = b2 + kstep;
            PG8_LDB(B0, 0, 0); PG8_LDB(B1, 0, 1); PG8_SCHED; PG8_LDA(At, 0, 0); PG8_STAGE(PG8_SA(1, 1), a1 + hstepA, voffA);
            PG8_WAIT_V(8); PG8_WAIT_L(0); PG8_BAR; PG8_MMA(0, 0, At, B0); PG8_MMA(0, 1, At, B1); PG8_BAR; PG8_SCHED;
            PG8_LDA(At, 0, 1); PG8_STAGE(PG8_SB(0, 0), b2, voffB); PG8_STAGE(PG8_SB(0, 1), b2 + hstepB, voffB); PG8_STAGE(PG8_SA(0, 0), a2, voffA);
            PG8_WAIT_V(8); PG8_WAIT_L(0); PG8_BAR; PG8_MMA(1, 0, At, B0); PG8_MMA(1, 1, At, B1); PG8_BAR; PG8_SCHED;
            PG8_LDB(B0, 1, 0); PG8_LDB(B1, 1, 1); PG8_SCHED; PG8_LDA(At, 1, 0); PG8_STAGE(PG8_SA(0, 1), a2 + hstepA, voffA);
            PG8_WAIT_V(8); PG8_WAIT_L(0); PG8_BAR; PG8_MMA(0, 0, At, B0); PG8_MMA(0, 1, At, B1); PG8_BAR; PG8_SCHED;
            PG8_LDA(At, 1, 1); PG8_STAGE(PG8_SB(1, 0), b3, voffB); PG8_STAGE(PG8_SB(1, 1), b3 + hstepB, voffB); PG8_STAGE(PG8_SA(1, 0), a3, voffA);
            PG8_WAIT_V(8); PG8_WAIT_L(0); PG8_BAR; PG8_MMA(1, 0, At, B0); PG8_MMA(1, 1, At, B1); PG8_BAR; PG8_SCHED;
        }
        if (wr == 0) PG8_BAR;
        E(acc, cur, part, wr, wc, fr, fq);
        if (!has_next) break;
        if (!DUAL || part == 1)
#pragma unroll
        for (int a = 0; a < 2; ++a)
#pragma unroll
            for (int b = 0; b < 2; ++b)
#pragma unroll
                for (int m = 0; m < 4; ++m)
#pragma unroll
                    for (int n = 0; n < 2; ++n) acc[a][b][m][n] = (f32x4){0.f, 0.f, 0.f, 0.f};
        cur = nxt; cA = nA; cB = nB; if (!DUAL || part == 1) ++ui; part = npart;
        if (wr == 1) PG8_BAR;
    }
    PG8_WAIT_V(0);
    PG8_BAR;
#undef PG8_SA
#undef PG8_SB
#undef PG8_STAGE
#undef PG8_LDA
#undef PG8_LDB
#undef PG8_MMA
#undef PG8_WAIT_V
#undef PG8_WAIT_L
#undef PG8_BAR
#undef PG8_SCHED
}
}
using pg8::Unit; using pg8::pack8; using pg8::unpack8;

#define EPI_FENCE() asm volatile("" ::: "memory")
__device__ __forceinline__ float sigmoidf_(float x) { return __builtin_amdgcn_rcpf(1.0f + __builtin_amdgcn_exp2f(-x * LOG2E)); }

#define LAUNDER_V(x) asm volatile("" : "+v"(x))
#define ST16(base, off, v) (*(u32x4*)((char*)(base) + (off)) = (v))
#define ST16F(base, off, v) (*(f32x4*)((char*)(base) + (off)) = (v))
#define LD16(base, off) (*(const u32x4*)((const char*)(base) + (off)))
#define LD16F(base, off) (*(const f32x4*)((const char*)(base) + (off)))
struct EpiInProj {
    static constexpr bool IDEMPOTENT = true;
    unsigned char* ws; float* out;
    __device__ __forceinline__ void operator()(f32x4 (&acc)[2][2][4][2], const Unit& u, int part, int wr, int wc, int fr, int fq) const {
        const int pn = u.pn, pm = u.pm;
        const bool sample = pm >= MP / 256;
        unsigned lr0 = wr * 64 + fr, col8 = wc * 32 + 8 * fq;
        if (pn >= 2 && pn < 6) {
            LAUNDER_V(lr0); LAUNDER_V(col8);
            unsigned char* U = ws + WS_U + ((size_t)pm * 256 * CD + 128 * (pn - 2)) * 2;
            const unsigned vo = (lr0 * CD + col8) * 2;
#pragma unroll
            for (int ai = 0; ai < 2; ++ai) {
#pragma unroll
                for (int m = 0; m < 4; ++m) {
                    const f32x4 a0 = acc[ai][0][m][0] * acc[ai][1][m][0], a1 = acc[ai][0][m][1] * acc[ai][1][m][1];
                    ST16(U, vo + (ai * 128 + m * 16) * CD * 2, pack8(a0, a1));
                    if (m == 3) {
                        const int lr = (int)lr0 + ai * 128 + 48; float* d = nullptr; const int ch0 = 128 * (pn - 2) + (int)col8;
                        if (!sample) { if ((pm & 7) == 7 && lr >= 254) d = out + OFF_CONVP + ((size_t)((pm >> 3) * 2 + (lr - 254)) * CD + ch0); }
                        else { const int t = lr & 63, b = (pm - MP / 256) * 4 + (lr >> 6); if (t >= DSEQ - 2) d = out + OFF_CONVS + ((size_t)(b * 2 + (t - (DSEQ - 2))) * CD + ch0); }
                        if (d) { *(f32x4*)d = a0; *(f32x4*)(d + 4) = a1; }
                    }
                }
                EPI_FENCE();
            }
        } else if (pn < 8) {
            LAUNDER_V(lr0); LAUNDER_V(col8);
            unsigned char* dst = ws + (pn < 2 ? WS_CB : WS_Q) + ((size_t)pm * 256 * 512 + 256 * (pn & 1)) * 2; const float sc = pn < 2 ? 1.0f : C2;
            const unsigned vo = (lr0 * 512 + col8) * 2;
#pragma unroll
            for (int ai = 0; ai < 2; ++ai) {
#pragma unroll
                for (int m = 0; m < 4; ++m)
#pragma unroll
                    for (int bj = 0; bj < 2; ++bj) ST16(dst, vo + ((ai * 128 + m * 16) * 512 + bj * 128) * 2, pack8(acc[ai][bj][m][0] * sc, acc[ai][bj][m][1] * sc));
                EPI_FENCE();
            }
        } else if (pn < 12) {
            LAUNDER_V(lr0); LAUNDER_V(col8);
            const bool isV = pn >= 10; const int cb0 = 256 * (pn & 1);
            if (!sample) {
                unsigned char* db = ws + (isV ? WS_VB : WS_KB) + ((size_t)pm * 256 * 512 + cb0) * 2;
                const unsigned vo = (lr0 * 512 + col8) * 2;
#pragma unroll
                for (int ai = 0; ai < 2; ++ai) {
#pragma unroll
                    for (int m = 0; m < 4; ++m)
#pragma unroll
                        for (int bj = 0; bj < 2; ++bj) ST16(db, vo + ((ai * 128 + m * 16) * 512 + bj * 128) * 2, pack8(acc[ai][bj][m][0], acc[ai][bj][m][1]));
                    EPI_FENCE();
                }
                if ((pm & 7) >= 6) {
                    float* df = out + (isV ? OFF_VP : OFF_KP) + (size_t)((pm >> 3) * KVR + ((pm & 7) - 6) * 256) * 512 + cb0;
                    const unsigned vf = (lr0 * 512 + col8) * 4;
#pragma unroll
                    for (int ai = 0; ai < 2; ++ai) {
#pragma unroll
                        for (int m = 0; m < 4; ++m)
#pragma unroll
                            for (int bj = 0; bj < 2; ++bj) { const unsigned o = vf + ((ai * 128 + m * 16) * 512 + bj * 128) * 4; ST16F(df, o, acc[ai][bj][m][0]); ST16F(df, o + 16, acc[ai][bj][m][1]); }
                        EPI_FENCE();
                    }
                }
            } else {
                const unsigned t0 = lr0 & 63, bq = lr0 >> 6;
                const unsigned vo = (t0 * 512 + col8) * 2, vf = (t0 * 512 + col8) * 4;
#pragma unroll
                for (int ai = 0; ai < 2; ++ai) {
                    const int b = (pm - MP / 256) * 4 + __builtin_amdgcn_readfirstlane(bq) + 2 * ai;
                    unsigned char* db = ws + (isV ? WS_VS : WS_KS) + ((size_t)(b * KSR + KVR) * 512 + cb0) * 2;
                    float* df = out + (isV ? OFF_VS : OFF_KS) + (size_t)(b * KVR + (KVR - DSEQ)) * 512 + cb0;
#pragma unroll
                    for (int m = 0; m < 4; ++m)
#pragma unroll
                        for (int bj = 0; bj < 2; ++bj) { ST16(db, vo + (m * 16 * 512 + bj * 128) * 2, pack8(acc[ai][bj][m][0], acc[ai][bj][m][1]));
                            const unsigned o = vf + (m * 16 * 512 + bj * 128) * 4; ST16F(df, o, acc[ai][bj][m][0]); ST16F(df, o + 16, acc[ai][bj][m][1]); }
                    EPI_FENCE();
                }
            }
        } else {
            LAUNDER_V(lr0); LAUNDER_V(col8);
            unsigned char* rat = ws + WS_RAT + ((size_t)pm * 256 * D + 128 * (pn - 12)) * 2; unsigned char* sgb = ws + WS_SGB + ((size_t)pm * 256 * D + 128 * (pn - 12)) * 2;
            const unsigned vo = (lr0 * D + col8) * 2;
#pragma unroll
            for (int ai = 0; ai < 2; ++ai) {
#pragma unroll
                for (int m = 0; m < 4; ++m) { f32x4 r0, r1, s0, s1;
#pragma unroll
                    for (int e = 0; e < 4; ++e) { const float ea0 = __builtin_amdgcn_exp2f(-acc[ai][0][m][0][e] * LOG2E) + 1.0f, eb0 = __builtin_amdgcn_exp2f(-acc[ai][1][m][0][e] * LOG2E) + 1.0f;
                        const float ea1 = __builtin_amdgcn_exp2f(-acc[ai][0][m][1][e] * LOG2E) + 1.0f, eb1 = __builtin_amdgcn_exp2f(-acc[ai][1][m][1][e] * LOG2E) + 1.0f;
                        r0[e] = eb0 * __builtin_amdgcn_rcpf(ea0); r1[e] = eb1 * __builtin_amdgcn_rcpf(ea1); s0[e] = __builtin_amdgcn_rcpf(eb0); s1[e] = __builtin_amdgcn_rcpf(eb1); }
                    ST16(rat, vo + (ai * 128 + m * 16) * D * 2, pack8(r0, r1)); ST16(sgb, vo + (ai * 128 + m * 16) * D * 2, pack8(s0, s1)); }
                EPI_FENCE();
            }
        }
    }
};

struct EpiMerge {
    static constexpr bool IDEMPOTENT = true;
    unsigned char* ws;
    __device__ __forceinline__ void operator()(f32x4 (&acc)[2][2][4][2], const Unit& u, int part, int wr, int wc, int fr, int fq) const {
        const size_t tb = ((size_t)u.pm * 256 * D + u.pn * 256) * 2;
        const unsigned char* G = ws + (part ? WS_SGB : WS_RAT) + tb; unsigned char* T = ws + WS_R1 + tb;
        unsigned lr0 = wr * 64 + fr, col8 = wc * 32 + 8 * fq; LAUNDER_V(lr0); LAUNDER_V(col8);
        const unsigned vo = (lr0 * D + col8) * 2;
#pragma unroll
        for (int ai = 0; ai < 2; ++ai)
#pragma unroll
            for (int m = 0; m < 4; ++m) {
                u32x4 gw[2];
#pragma unroll
                for (int bj = 0; bj < 2; ++bj) gw[bj] = LD16(G, vo + ((ai * 128 + m * 16) * D + bj * 128) * 2);
#pragma unroll
                for (int bj = 0; bj < 2; ++bj) { f32x4 g0, g1; unpack8(gw[bj], g0, g1); acc[ai][bj][m][0] *= g0; acc[ai][bj][m][1] *= g1;
                    if (part) ST16(T, vo + ((ai * 128 + m * 16) * D + bj * 128) * 2, pack8(acc[ai][bj][m][0], acc[ai][bj][m][1])); }
                if (m & 1) EPI_FENCE(); }
    }
};

template <bool FIRST> struct EpiResid {
    static constexpr bool IDEMPOTENT = false;
    const float* xp; const float* xs;
    unsigned char* ws; float* out; int skip_ss;
    __device__ __forceinline__ void operator()(f32x4 (&acc)[2][2][4][2], const Unit& u, int part, int wr, int wc, int fr, int fq) const {
        const size_t grow0 = (size_t)u.pm * 256; const int cb = u.pn * 256;
        unsigned char* xb = ws + WS_R2 + (grow0 * D + cb) * 2;
        const float* src = nullptr; float* of = nullptr; float* ss;
        if (FIRST) { src = ((u.pm >= MP / 256) ? xs + (grow0 - MP) * D : xp + grow0 * D) + cb; ss = (float*)(ws + CTL_SS1) + grow0; }
        else { of = out + OFF_Y + grow0 * D + cb; ss = (float*)(ws + CTL_SS2) + grow0; }
        unsigned lr0 = wr * 64 + fr, col8 = wc * 32 + 8 * fq; LAUNDER_V(lr0); LAUNDER_V(col8);
        const unsigned ve = lr0 * D + col8;
#pragma unroll
        for (int ai = 0; ai < 2; ++ai)
#pragma unroll
            for (int m = 0; m < 4; ++m) {
                f32x4 r[2][2];
#pragma unroll
                for (int bj = 0; bj < 2; ++bj) { const unsigned e = ve + (ai * 128 + m * 16) * D + bj * 128;
                    if (FIRST) { r[bj][0] = LD16F(src, e * 4); r[bj][1] = LD16F(src, e * 4 + 16); } else unpack8(LD16(xb, e * 2), r[bj][0], r[bj][1]); }
                float s = 0.f;
#pragma unroll
                for (int bj = 0; bj < 2; ++bj) { const unsigned e = ve + (ai * 128 + m * 16) * D + bj * 128;
                    const f32x4 v0 = acc[ai][bj][m][0] + r[bj][0], v1 = acc[ai][bj][m][1] + r[bj][1];
                    if (FIRST) ST16(xb, e * 2, pack8(v0, v1)); else { ST16F(of, e * 4, v0); ST16F(of, e * 4 + 16, v1); }
                    s += (v0[0] * v0[0] + v0[1] * v0[1]) + (v0[2] * v0[2] + v0[3] * v0[3]) + (v1[0] * v1[0] + v1[1] * v1[1]) + (v1[2] * v1[2] + v1[3] * v1[3]); }
                s += __shfl_xor(s, 16); s += __shfl_xor(s, 32);
                if (fq == 0 && !skip_ss) unsafeAtomicAdd(ss + lr0 + ai * 128 + m * 16, s);
                if (m & 1) EPI_FENCE(); }
    }
};

struct EpiSwiGLU {
    static constexpr bool IDEMPOTENT = true;
    unsigned char* ws;
    __device__ __forceinline__ void operator()(f32x4 (&acc)[2][2][4][2], const Unit& u, int part, int wr, int wc, int fr, int fq) const {
        const size_t grow0 = (size_t)u.pm * 256;
        const float* ss = (const float*)(ws + CTL_SS1) + grow0; unsigned char* H = ws + WS_H + (grow0 * DFF + u.pn * 128) * 2;
        unsigned lr0 = wr * 64 + fr, col8 = wc * 32 + 8 * fq; LAUNDER_V(lr0); LAUNDER_V(col8);
        const unsigned vo = (lr0 * DFF + col8) * 2;
        float rs[2][4];
#pragma unroll
        for (int ai = 0; ai < 2; ++ai)
#pragma unroll
            for (int m = 0; m < 4; ++m) rs[ai][m] = __builtin_amdgcn_rsqf(ss[lr0 + ai * 128 + m * 16] * (1.0f / D) + EPS);
#pragma unroll
        for (int ai = 0; ai < 2; ++ai)
#pragma unroll
            for (int m = 0; m < 4; ++m) { const float r = rs[ai][m]; f32x4 h[2];
#pragma unroll
                for (int n = 0; n < 2; ++n)
#pragma unroll
                    for (int e = 0; e < 4; ++e) { const float gv = acc[ai][0][m][n][e] * r, uv = acc[ai][1][m][n][e] * r; h[n][e] = gv * sigmoidf_(gv) * uv; }
                ST16(H, vo + (ai * 128 + m * 16) * DFF * 2, pack8(h[0], h[1])); }
    }
};

__device__ __forceinline__ void glds16(const void* gsrc, unsigned lds_dst) { unsigned keep;
    asm volatile("s_mov_b32 %0, m0\n\ts_mov_b32 m0, %2\n\ts_nop 0\n\tglobal_load_lds_dwordx4 %1, off\n\ts_mov_b32 m0, %0" : "=&s"(keep) : "v"(gsrc), "s"(lds_dst) : "memory"); }
typedef short v4i16_t __attribute__((ext_vector_type(4)));
__device__ __forceinline__ s16x4 vtr(const LAS unsigned char* p) { return __builtin_bit_cast(s16x4, __builtin_amdgcn_ds_read_tr16_b64_v4i16((LAS v4i16_t*)p)); }
__device__ __forceinline__ float swapmax(float v) { auto rr = __builtin_amdgcn_permlane32_swap(__float_as_uint(v), __float_as_uint(v), false, false); return fmaxf(__uint_as_float(rr[0]), __uint_as_float(rr[1])); }
__device__ __forceinline__ float swapsum(float v) { auto rr = __builtin_amdgcn_permlane32_swap(__float_as_uint(v), __float_as_uint(v), false, false); return __uint_as_float(rr[0]) + __uint_as_float(rr[1]); }

__device__ __forceinline__ void attn_unit(LAS unsigned char* wl, unsigned lds0w, const LAS float* tb, const bf16_t* Qp, const bf16_t* Kp, const bf16_t* Vp, int ntiles, bf16_t* Op, int lane) {
    const int r32 = lane & 31, hi = lane >> 5;
    bf16x8 qf[2][4];
#pragma unroll
    for (int qb = 0; qb < 2; ++qb)
#pragma unroll
        for (int d0 = 0; d0 < 4; ++d0) qf[qb][d0] = *(const bf16x8*)(Qp + (size_t)(32 * qb + r32) * 512 + 16 * d0 + 8 * hi);
    f32x16 o[2][2];
#pragma unroll
    for (int a = 0; a < 2; ++a)
#pragma unroll
        for (int b = 0; b < 2; ++b)
#pragma unroll
            for (int r = 0; r < 16; ++r) o[a][b][r] = 0.f;
    float mrun[2] = {-1e30f, -1e30f}, lrun[2] = {0.f, 0.f};
    const int pos = lane & 7, lrow = lane >> 3, x4 = lane >> 4;
    const unsigned koff0 = lrow * 1024 + ((pos ^ x4) * 16), koff1 = lrow * 1024 + ((pos ^ x4 ^ 4) * 16), voff = lrow * 1024 + ((pos ^ ((x4 & 1) << 2)) * 16);
    const unsigned kdst = lds0w, vdst = lds0w + 8192;
#define DMA_K(t) do { const char* _s = (const char*)Kp + (size_t)(t) * 65536; _Pragma("unroll") for (int _i = 0; _i < 8; ++_i) glds16(_s + _i * 8192 + ((_i & 1) ? koff1 : koff0), (unsigned)__builtin_amdgcn_readfirstlane(kdst + _i * 1024)); } while (0)
#define DMA_V(t) do { const char* _s = (const char*)Vp + (size_t)(t) * 65536; _Pragma("unroll") for (int _i = 0; _i < 8; ++_i) glds16(_s + _i * 8192 + voff, (unsigned)__builtin_amdgcn_readfirstlane(vdst + _i * 1024)); } while (0)
    const int xk = (r32 >> 1) & 7;
    const LAS unsigned char* kb[4];
#pragma unroll
    for (int d0 = 0; d0 < 4; ++d0) kb[d0] = wl + r32 * 128 + (((2 * d0 + hi) ^ xk) * 16);
    const int vl = (4 * hi + ((lane & 15) >> 2)) * 128 + (2 * ((lane >> 4) & 1) + ((lane & 3) >> 1)) * 16 + 8 * (lane & 1);
    const LAS unsigned char* vb[2];
    vb[0] = wl + 8192 + vl + 64 * (0 ^ ((lane >> 3) & 1)); vb[1] = wl + 8192 + vl + 64 * (1 ^ ((lane >> 3) & 1));
    DMA_K(0); DMA_V(0);
    for (int t = 0; t < ntiles; ++t) {
        const int dc = ntiles - 1 - t; const bool more = (t + 1 < ntiles);
        f32x16 s[2][2];
        if (dc <= 2) {
            const LAS float* bp = tb + (128 + 64 * dc + r32 - 4 * hi - 59);
#pragma unroll
            for (int kvb = 0; kvb < 2; ++kvb)
#pragma unroll
                for (int qb = 0; qb < 2; ++qb)
#pragma unroll
                    for (int r = 0; r < 16; ++r) s[kvb][qb][r] = bp[59 + 32 * (qb - kvb) - ((r & 3) + 8 * (r >> 2))];
        } else {
            const float c = tb[256];
#pragma unroll
            for (int kvb = 0; kvb < 2; ++kvb)
#pragma unroll
                for (int qb = 0; qb < 2; ++qb)
#pragma unroll
                    for (int r = 0; r < 16; ++r) s[kvb][qb][r] = c;
        }
        asm volatile("s_waitcnt vmcnt(8)" ::: "memory");
#pragma unroll
        for (int kvb = 0; kvb < 2; ++kvb)
#pragma unroll
            for (int d0 = 0; d0 < 4; ++d0) { const bf16x8 kf = *(const LAS bf16x8*)(kb[d0] + kvb * 4096);
                s[kvb][0] = __builtin_amdgcn_mfma_f32_32x32x16_bf16(kf, qf[0][d0], s[kvb][0], 0, 0, 0);
                s[kvb][1] = __builtin_amdgcn_mfma_f32_32x32x16_bf16(kf, qf[1][d0], s[kvb][1], 0, 0, 0); }
        asm volatile("s_waitcnt lgkmcnt(0)" ::: "memory");
        if (more) DMA_K(t + 1);
        bf16x8 pf[2][4];
#pragma unroll
        for (int qb = 0; qb < 2; ++qb) {
            float mx = s[0][qb][0];
#pragma unroll
            for (int r = 1; r < 16; ++r) mx = fmaxf(mx, s[0][qb][r]);
#pragma unroll
            for (int r = 0; r < 16; ++r) mx = fmaxf(mx, s[1][qb][r]);
            mx = swapmax(mx);
            const float mn = fmaxf(mrun[qb], mx), alpha = __builtin_amdgcn_exp2f(mrun[qb] - mn); mrun[qb] = mn;
            float ls = 0.f;
#pragma unroll
            for (int kvb = 0; kvb < 2; ++kvb)
#pragma unroll
                for (int r = 0; r < 16; ++r) { const float p = __builtin_amdgcn_exp2f(s[kvb][qb][r] - mn); s[kvb][qb][r] = p; ls += p; }
            lrun[qb] = lrun[qb] * alpha + ls;
#pragma unroll
            for (int db = 0; db < 2; ++db)
#pragma unroll
                for (int r = 0; r < 16; ++r) o[db][qb][r] *= alpha;
#pragma unroll
            for (int si = 0; si < 4; ++si) { const int kvb = si >> 1, r0 = 8 * (si & 1); u32x4 w;
                w.x = pg8::cvt_pk_bf16(s[kvb][qb][r0 + 0], s[kvb][qb][r0 + 1]); w.y = pg8::cvt_pk_bf16(s[kvb][qb][r0 + 2], s[kvb][qb][r0 + 3]);
                w.z = pg8::cvt_pk_bf16(s[kvb][qb][r0 + 4], s[kvb][qb][r0 + 5]); w.w = pg8::cvt_pk_bf16(s[kvb][qb][r0 + 6], s[kvb][qb][r0 + 7]);
                pf[qb][si] = __builtin_bit_cast(bf16x8, w); }
        }
        if (more) asm volatile("s_waitcnt vmcnt(8)" ::: "memory"); else asm volatile("s_waitcnt vmcnt(0)" ::: "memory");
#pragma unroll
        for (int si = 0; si < 4; ++si)
#pragma unroll
            for (int db = 0; db < 2; ++db) { const s16x4 lo = vtr(vb[db] + si * 2048), h4 = vtr(vb[db] + si * 2048 + 1024);
                const bf16x8 vf = (bf16x8){lo[0], lo[1], lo[2], lo[3], h4[0], h4[1], h4[2], h4[3]};
                o[db][0] = __builtin_amdgcn_mfma_f32_32x32x16_bf16(vf, pf[0][si], o[db][0], 0, 0, 0);
                o[db][1] = __builtin_amdgcn_mfma_f32_32x32x16_bf16(vf, pf[1][si], o[db][1], 0, 0, 0); }
        asm volatile("s_waitcnt lgkmcnt(0)" ::: "memory");
        if (more) DMA_V(t + 1);
    }
#undef DMA_K
#undef DMA_V
#pragma unroll
    for (int qb = 0; qb < 2; ++qb) { const float inv = 1.0f / swapsum(lrun[qb]); bf16_t* orow = Op + (size_t)(32 * qb + r32) * 1024 + 4 * hi;
#pragma unroll
        for (int db = 0; db < 2; ++db)
#pragma unroll
            for (int g4 = 0; g4 < 4; ++g4) { u32x2 w; w.x = pg8::cvt_pk_bf16(o[db][qb][4 * g4 + 0] * inv, o[db][qb][4 * g4 + 1] * inv); w.y = pg8::cvt_pk_bf16(o[db][qb][4 * g4 + 2] * inv, o[db][qb][4 * g4 + 3] * inv);
                *(u32x2*)(orow + 32 * db + 8 * g4) = w; } }
}

struct Args { const float* in[17]; float* out; unsigned char* ws; int ph_lo, ph_hi; };
static_assert(sizeof(Args) == 19 * 8 + 8, "Args has no padding");

__device__ __forceinline__ unsigned f2bf(float f) { unsigned u = __builtin_bit_cast(unsigned, f); return (u + 0x7fffu + ((u >> 16) & 1u)) >> 16; }
__device__ __forceinline__ unsigned pk2(float lo, float hi) { return f2bf(lo) | (f2bf(hi) << 16); }
__device__ __forceinline__ float wave_sum(float v) {
#pragma unroll
    for (int o = 1; o < 64; o <<= 1) v += __shfl_xor(v, o);
    return v;
}
__device__ __forceinline__ void transpose_item(const float* W, int ldn, int col0, int k0, const float* scale, bf16_t* WT, int K, int nrow0, LAS float* scr, int lane) {
#pragma unroll 8
    for (int i = 0; i < 32; ++i) { const int kk = 2 * i + (lane >> 5); float v = W[(size_t)(k0 + kk) * ldn + col0 + (lane & 31)]; if (scale) v *= scale[k0 + kk]; scr[kk * 33 + (lane & 31)] = v; }
    asm volatile("s_waitcnt lgkmcnt(0)" ::: "memory");
    const int c = lane & 7;
#pragma unroll
    for (int j = 0; j < 4; ++j) { const int n = (lane >> 3) + 8 * j; const LAS float* s = scr + (8 * c) * 33 + n;
        u32x4 o; o.x = pk2(s[0 * 33], s[1 * 33]); o.y = pk2(s[2 * 33], s[3 * 33]); o.z = pk2(s[4 * 33], s[5 * 33]); o.w = pk2(s[6 * 33], s[7 * 33]);
        *(u32x4*)(WT + (size_t)(nrow0 + n) * K + k0 + 8 * c) = o; }
    asm volatile("s_waitcnt lgkmcnt(0)" ::: "memory");
}

#define XB_TMO      128
#define XB_XCNT(j)  (256  + 64 * (j))
#define XB_XSUB(j)  (1280 + 64 * (j))
#define XB_XGEN(j)  (2304 + 64 * (j))
#define XB_TOP      3328
#define XB_TOPGEN   3392
#define XCD_BAR_WORDS 3456
#define XB_SPIN_CAP (1u << 18)
__device__ __forceinline__ unsigned xb_ld(unsigned* p)              { return __hip_atomic_load(p, __ATOMIC_RELAXED, __HIP_MEMORY_SCOPE_AGENT); }
__device__ __forceinline__ unsigned xb_add(unsigned* p, unsigned v) { return __hip_atomic_fetch_add(p, v, __ATOMIC_RELAXED, __HIP_MEMORY_SCOPE_AGENT); }
__device__ __forceinline__ unsigned xb_xcc_id() { return (unsigned)__builtin_amdgcn_s_getreg((3 << 11) | 20) & 0xFu; }
#define XB_SPIN(cond, bar) do { unsigned _sp = 0; while (cond) { __builtin_amdgcn_s_sleep(1); \
    if ((++_sp & 255u) == 0u) { if (xb_ld(&(bar)[XB_TMO])) break; if (_sp > XB_SPIN_CAP) { atomicAdd(&(bar)[XB_TMO], 1u); break; } } } } while (0)
__device__ __forceinline__ void xcd_barrier_complete(unsigned* bar, unsigned x, unsigned& nloc, unsigned& nx) {
    const unsigned G = gridDim.x * gridDim.y * gridDim.z;
    unsigned sum, cnt, mine, sp = 0u;
    for (;;) {
        sum = 0u; cnt = 0u; mine = 0u;
#pragma unroll
        for (unsigned j = 0; j < 16; ++j) { const unsigned c = xb_ld(&bar[XB_XCNT(j)]); sum += c; cnt += (c > 0u) ? 1u : 0u; mine = (j == x) ? c : mine; }
        if (sum == G) break;
        __builtin_amdgcn_s_sleep(1);
        if ((++sp & 255u) == 0u) { if (xb_ld(&bar[XB_TMO])) break; if (sp > XB_SPIN_CAP) { atomicAdd(&bar[XB_TMO], 1u); break; } }
    }
    nloc = mine > 0u ? mine : 1u; nx = cnt > 0u ? cnt : 1u;
}
__device__ __forceinline__ void xcd_barrier(unsigned* bar, volatile LAS unsigned* st) {
    asm volatile("s_waitcnt vmcnt(0)" ::: "memory");
    __syncthreads();
    if (threadIdx.x == 0) {
        __builtin_amdgcn_s_waitcnt(0);
        const unsigned x = xb_xcc_id();
        unsigned nloc = st[0], nx = st[1];
        if (nloc == 0u) { xcd_barrier_complete(bar, x, nloc, nx); st[0] = nloc; st[1] = nx; }
        const unsigned old = xb_add(&bar[XB_XSUB(x)], 1u);
        const unsigned gen = old / nloc;
        if (old + 1u == (gen + 1u) * nloc) {
            __builtin_amdgcn_fence(__ATOMIC_RELEASE, "agent");
            asm volatile("s_waitcnt vmcnt(0)" ::: "memory");
            const unsigned og = xb_add(&bar[XB_TOP], 1u);
            const unsigned tg = og / nx;
            if (og + 1u == (tg + 1u) * nx) xb_add(&bar[XB_TOPGEN], 1u);
            else XB_SPIN(xb_ld(&bar[XB_TOPGEN]) == tg, bar);
            __builtin_amdgcn_fence(__ATOMIC_ACQUIRE, "agent");
            xb_add(&bar[XB_XGEN(x)], 1u);
            asm volatile("s_waitcnt vmcnt(0)" ::: "memory");
        } else {
            XB_SPIN(xb_ld(&bar[XB_XGEN(x)]) == gen, bar);
            __builtin_amdgcn_fence(__ATOMIC_ACQUIRE, "agent");
            asm volatile("s_waitcnt vmcnt(0)" ::: "memory");
        }
    }
    __syncthreads();
}

typedef const char __attribute__((address_space(4)))* kptr_t;
__device__ __forceinline__ const void* karg(int k) { kptr_t ka = (kptr_t)__builtin_amdgcn_kernarg_segment_ptr(); asm volatile("" : "+s"(ka)); return *(const void* const __attribute__((address_space(4)))*)(ka + 8 * k); }
#define KIN(k) ((const float*)karg(k))
#define KOUT() ((float*)karg(17))
#define KWS() ((unsigned char*)karg(18))

__global__ void __launch_bounds__(512, 2) fwd_kernel(Args args) {
    extern __shared__ __attribute__((aligned(16))) unsigned char lds_raw[];
    LAS unsigned char* lds = (LAS unsigned char*)lds_raw;
    { volatile LAS unsigned* st0 = (volatile LAS unsigned*)(lds + MISC_OFF + 32); if (threadIdx.x < 2) st0[threadIdx.x] = 0u; __syncthreads();
      if (threadIdx.x == 0) (void)xb_add((unsigned*)(KWS() + CTL_BAR) + XB_XCNT(xb_xcc_id()), 1u); }
    const int lo = args.ph_lo, hi = args.ph_hi;
#ifndef PH_MASK
#define PH_MASK 0x1ff
#endif
#define IN(k) (((PH_MASK >> (k)) & 1) && lo <= (k) && (k) < hi)
#ifndef STAG1
#define STAG1 2800
#endif
#ifndef STAG5
#define STAG5 2800
#endif
#ifndef REPEAT_MASK
#define REPEAT_MASK 0
#endif
#define REP(k) for (int rep_ = 0; rep_ < 1 + ((REPEAT_MASK >> (k)) & 1); ++rep_)
#define GRID_BAR() xcd_barrier((unsigned*)(KWS() + CTL_BAR), (volatile LAS unsigned*)(lds + MISC_OFF + 32))
#define SEAM(k) do { if (IN(k) && IN((k) + 1)) GRID_BAR(); } while (0)
#define GEOM() int tid_ = threadIdx.x; asm volatile("" : "+v"(tid_)); const int tid = tid_, lane = tid & 63, wave = __builtin_amdgcn_readfirstlane(tid >> 6); const int G = gridDim.x, bx = blockIdx.x; \
    const int vcu = (G % 8 == 0) ? (bx % 8) * (G / 8) + bx / 8 : bx; (void)lane; (void)wave; (void)vcu; (void)tid

    if (IN(0)) REP(0) {
        GEOM();
        unsigned char* ws = KWS();
        LAS float* scr = (LAS float*)(lds + wave * 16384);
        const int gw = vcu * 8 + wave, NGW = G * 8;
        constexpr int I_IN = (D / 64) * (NIN / 32), I_CO = (CD / 64) * (D / 32), I_AO = I_CO, I_OUT = (D / 64) * (D / 32), I_13 = (D / 64) * (NFF / 32), I_2 = (DFF / 64) * (D / 32);
        constexpr int NITEMS = I_IN + I_CO + I_AO + I_OUT + I_13 + I_2;
        for (int it = gw; it < NITEMS; it += NGW) {
            int r = it;
            if (r < I_IN) { const int nb = r % (NIN / 32), kb = r / (NIN / 32); const int tile = nb >> 3, w = nb & 7; int col0 = 32 * nb;
                if (tile >= 2 && tile < 6) col0 = (w < 4) ? (512 + 128 * (tile - 2) + 32 * w) : (1024 + 128 * (tile - 2) + 32 * (w - 4));
                if (tile >= 12) col0 = (w < 4) ? (3072 + 128 * (tile - 12) + 32 * w) : (4096 + 128 * (tile - 12) + 32 * (w - 4));
                transpose_item(KIN(6), NIN, col0, 64 * kb, nullptr, (bf16_t*)(ws + WS_WIN), D, 32 * nb, scr, lane); continue; } r -= I_IN;
            if (r < I_CO) { const int nb = r % (D / 32), kb = r / (D / 32); transpose_item(KIN(8), D, 32 * nb, 64 * kb, nullptr, (bf16_t*)(ws + WS_WCO), CD, 32 * nb, scr, lane); continue; } r -= I_CO;
            if (r < I_AO) { const int nb = r % (D / 32), kb = r / (D / 32); transpose_item(KIN(10), D, 32 * nb, 64 * kb, nullptr, (bf16_t*)(ws + WS_WAO), AD, 32 * nb, scr, lane); continue; } r -= I_AO;
            if (r < I_OUT) { const int nb = r % (D / 32), kb = r / (D / 32); transpose_item(KIN(11), D, 32 * nb, 64 * kb, nullptr, (bf16_t*)(ws + WS_WOUT), D, 32 * nb, scr, lane); continue; } r -= I_OUT;
            if (r < I_13) { const int nb = r % (NFF / 32), kb = r / (NFF / 32); const int tile = nb >> 3, w = nb & 7;
                const float* src = (w < 4) ? KIN(13) : KIN(14); const int col0 = 128 * tile + 32 * (w & 3);
                transpose_item(src, DFF, col0, 64 * kb, KIN(12), (bf16_t*)(ws + WS_W13), D, 32 * nb, scr, lane); continue; } r -= I_13;
            { const int nb = r % (D / 32), kb = r / (D / 32); transpose_item(KIN(15), D, 32 * nb, 64 * kb, nullptr, (bf16_t*)(ws + WS_W2), DFF, 32 * nb, scr, lane); }
        }
        {
            const float* x_prompt = KIN(0); const float* x_sample = KIN(1); const float* g_mix = KIN(5); bf16_t* R1 = (bf16_t*)(ws + WS_R1);
            for (int m = gw; m < M; m += NGW) {
                const float* xrow = (m < MP) ? x_prompt + (size_t)m * D : x_sample + (size_t)(m - MP) * D;
                const f32x4* xr = (const f32x4*)xrow + lane; const f32x4* gr = (const f32x4*)g_mix + lane;
                f32x4 v[4]; float s = 0.f;
#pragma unroll
                for (int j = 0; j < 4; ++j) { v[j] = xr[64 * j]; s += (v[j].x * v[j].x + v[j].y * v[j].y) + (v[j].z * v[j].z + v[j].w * v[j].w); }
                const float rstd = 1.0f / sqrtf(wave_sum(s) * (1.0f / D) + EPS);
                u32x2* o8 = (u32x2*)(R1 + (size_t)m * D) + lane;
#pragma unroll
                for (int j = 0; j < 4; ++j) { const f32x4 gg = gr[64 * j]; u32x2 w; w.x = pk2(v[j].x * rstd * gg.x, v[j].y * rstd * gg.y); w.y = pk2(v[j].z * rstd * gg.z, v[j].w * rstd * gg.w); o8[64 * j] = w; }
            }
        }
        {
            const float* cache_k = KIN(3); const float* cache_v = KIN(4); float* out = KOUT();
            for (int it = gw; it < 2 * NB * KVR; it += NGW) {
                const int isV = it >= NB * KVR, rr = isV ? it - NB * KVR : it, b = rr / KVR, r = rr % KVR;
                const float* src = (isV ? cache_v : cache_k) + (size_t)rr * 512 + lane * 8;
                const f32x4 a = *(const f32x4*)src, c = *(const f32x4*)(src + 4);
                u32x4 w; w.x = pk2(a.x, a.y); w.y = pk2(a.z, a.w); w.z = pk2(c.x, c.y); w.w = pk2(c.z, c.w);
                *(u32x4*)((bf16_t*)(ws + (isV ? WS_VS : WS_KS)) + (size_t)(b * KSR + r) * 512 + lane * 8) = w;
                if (r >= DSEQ) { float* d = out + (isV ? OFF_VS : OFF_KS) + (size_t)(b * KVR + r - DSEQ) * 512 + lane * 8; *(f32x4*)d = a; *(f32x4*)(d + 4) = c; }
            }
        }
    }
    SEAM(0);

    if (IN(1)) REP(1) {
        unsigned char* ws = KWS();
        pg8::Gemm g{(const bf16_t*)(ws + WS_R1), (const bf16_t*)(ws + WS_WIN), M, NIN, D, D, D, nullptr, nullptr}; pg8::StaticOrder S; S.init(M, NIN, gridDim.x, blockIdx.x);
        EpiInProj E{ws, KOUT()};
        pg8::gemm_phase(lds, g, S, E);
    }
    SEAM(1);

    if (IN(2)) REP(2) {
        GEOM();
        unsigned char* ws = KWS();
        LAS float* tbl = (LAS float*)(lds + TBL_OFF);
        { const float* rel_bias = KIN(9);
          for (int i = tid; i < NH * TBL_STRIDE; i += 512) { const int h = i / TBL_STRIDE, j = i % TBL_STRIDE; tbl[i] = rel_bias[h * 257 + (j < 256 ? j : 256)] * LOG2E; } }
        __syncthreads();
        volatile LAS int* misc = (volatile LAS int*)(lds + MISC_OFF);
        const unsigned lds0 = (unsigned)(uintptr_t)lds_raw;
        constexpr int NUNITS = NB * (SEQ / 64) + NB;
        bf16_t* R2 = (bf16_t*)(ws + WS_R2);
        for (;;) {
            __syncthreads();
            if (tid == 0) misc[0] = (int)atomicAdd((unsigned*)(ws + WS_CTL) + 64 + 64 * rep_, 1u);
            __syncthreads();
            const int ui = misc[0];
            if (ui >= NUNITS) break;
            int b, c; bool smp = false;
            if (ui < 768) { const int grp = ui >> 8, w = ui & 255; b = w >> 3; c = 8 + 8 * grp + (w & 7); }
            else if (ui < 800) { smp = true; b = ui - 768; c = 0; }
            else { const int w = ui - 800; c = 7 - (w >> 5); b = w & 31; }
            const size_t row0 = smp ? (size_t)MP + (size_t)b * DSEQ : (size_t)b * SEQ + (size_t)c * 64;
            {
                const float* w_conv = KIN(7); const bf16_t* UB = (const bf16_t*)(ws + WS_U); const bf16_t* CB = (const bf16_t*)(ws + WS_CB);
                const int cb8 = (tid & 63) * 8, rg = tid >> 6;
                float w0[8], w1[8], w2[8];
#pragma unroll
                for (int e = 0; e < 8; ++e) { w0[e] = w_conv[cb8 + e]; w1[e] = w_conv[CD + cb8 + e]; w2[e] = w_conv[2 * CD + cb8 + e]; }
                f32x4 pa0, pa1, pb0, pb1;
                const size_t r0 = row0 + 8 * rg;
                if (rg == 0 && smp) { const float* sp = KIN(2) + (size_t)b * 2 * CD + cb8; pa0 = *(const f32x4*)sp; pa1 = *(const f32x4*)(sp + 4); pb0 = *(const f32x4*)(sp + CD); pb1 = *(const f32x4*)(sp + CD + 4); }
                else if (rg == 0 && c == 0) { pa0 = pa1 = pb0 = pb1 = (f32x4){0.f, 0.f, 0.f, 0.f}; }
                else { unpack8(*(const u32x4*)(UB + (r0 - 2) * CD + cb8), pa0, pa1); unpack8(*(const u32x4*)(UB + (r0 - 1) * CD + cb8), pb0, pb1); }
#pragma unroll
                for (int i = 0; i < 8; ++i) {
                    f32x4 c0, c1, e0, e1; unpack8(*(const u32x4*)(UB + (r0 + i) * CD + cb8), c0, c1); unpack8(*(const u32x4*)(CB + (r0 + i) * CD + cb8), e0, e1);
                    f32x4 y0, y1;
#pragma unroll
                    for (int e = 0; e < 4; ++e) { y0[e] = e0[e] * (w0[e] * pa0[e] + w1[e] * pb0[e] + w2[e] * c0[e]); y1[e] = e1[e] * (w0[4 + e] * pa1[e] + w1[4 + e] * pb1[e] + w2[4 + e] * c1[e]); }
                    *(u32x4*)(R2 + (r0 + i) * D + cb8) = pack8(y0, y1);
                    pa0 = pb0; pa1 = pb1; pb0 = c0; pb1 = c1;
                }
            }
            EPI_FENCE();
            {
                const int h = wave; int ntiles; const bf16_t *Kp, *Vp;
                if (smp) { ntiles = 9; Kp = (const bf16_t*)(ws + WS_KS) + (size_t)b * KSR * 512 + h * 64; Vp = (const bf16_t*)(ws + WS_VS) + (size_t)b * KSR * 512 + h * 64; }
                else { const int c0 = c > 8 ? c - 8 : 0; ntiles = c - c0 + 1; const size_t kr = (size_t)b * SEQ + (size_t)c0 * 64; Kp = (const bf16_t*)(ws + WS_KB) + kr * 512 + h * 64; Vp = (const bf16_t*)(ws + WS_VB) + kr * 512 + h * 64; }
                attn_unit(lds + wave * 16384, lds0 + wave * 16384, tbl + h * TBL_STRIDE, (const bf16_t*)(ws + WS_Q) + row0 * 512 + h * 64, Kp, Vp, ntiles, R2 + row0 * D + 512 + h * 64, lane);
            }
        }
    }
    SEAM(2);

    if (IN(3)) REP(3) {
        unsigned char* ws = KWS();
        pg8::Gemm g{(const bf16_t*)(ws + WS_R2), (const bf16_t*)(ws + WS_WCO), M, D, CD, D, CD, (const bf16_t*)(ws + WS_R2) + 512, (const bf16_t*)(ws + WS_WAO)}; pg8::StaticOrder S; S.init(M, D, gridDim.x, blockIdx.x);
        EpiMerge E{ws};
        pg8::gemm_phase<EpiMerge, true>(lds, g, S, E);
    }
    SEAM(3);
    if (IN(5)) REP(5) {
        unsigned char* ws = KWS();
        pg8::Gemm g{(const bf16_t*)(ws + WS_R1), (const bf16_t*)(ws + WS_WOUT), M, D, D, D, D, nullptr, nullptr}; pg8::StaticOrder S; S.init(M, D, gridDim.x, blockIdx.x);
        EpiResid<true> E{KIN(0), KIN(1), ws, nullptr, rep_};
        pg8::gemm_phase(lds, g, S, E);
    }
    SEAM(5);
    if (IN(6)) REP(6) {
        unsigned char* ws = KWS();
        pg8::Gemm g{(const bf16_t*)(ws + WS_R2), (const bf16_t*)(ws + WS_W13), M, NFF, D, D, D, nullptr, nullptr}; pg8::StaticOrder S; S.init(M, NFF, gridDim.x, blockIdx.x);
        EpiSwiGLU E{ws};
        pg8::gemm_phase(lds, g, S, E);
    }
    SEAM(6);
    if (IN(7)) REP(7) {
        unsigned char* ws = KWS();
        pg8::Gemm g{(const bf16_t*)(ws + WS_H), (const bf16_t*)(ws + WS_W2), M, D, DFF, DFF, DFF, nullptr, nullptr}; pg8::StaticOrder S; S.init(M, D, gridDim.x, blockIdx.x);
        EpiResid<false> E{nullptr, nullptr, ws, KOUT(), rep_};
        pg8::gemm_phase(lds, g, S, E);
    }
    SEAM(7);
    if (IN(8)) {
        GEOM();
        const float* SS2 = (const float*)(KWS() + CTL_SS2); float* out = KOUT();
        const int gw = vcu * 8 + wave, NGW = G * 8;
        const f32x4* gr = (const f32x4*)KIN(16) + lane;
        f32x4 gg[4];
#pragma unroll
        for (int j = 0; j < 4; ++j) gg[j] = gr[64 * j];
        for (int m = gw; m < M; m += NGW) {
            f32x4* yr = (f32x4*)(out + OFF_Y + (size_t)m * D) + lane;
            const float rs = 1.0f / sqrtf(SS2[m] * (1.0f / D) + EPS);
#pragma unroll
            for (int j = 0; j < 4; ++j) { f32x4 v = yr[64 * j]; v = v * rs * gg[j]; yr[64 * j] = v; }
        }
    }
#ifdef DBG_DUMP_OFF
    {
        GRID_BAR();
        GEOM();
        const bf16_t* src = (const bf16_t*)(KWS() + (size_t)DBG_DUMP_OFF); float* out = KOUT();
        const int gw = vcu * 8 + wave, NGW = G * 8;
        for (int m = gw; m < M; m += NGW) {
#pragma unroll
            for (int j = 0; j < 2; ++j) { f32x4 a, b; unpack8(*(const u32x4*)(src + (size_t)m * D + j * 512 + lane * 8), a, b); float* d = out + (size_t)m * D + j * 512 + lane * 8; *(f32x4*)d = a; *(f32x4*)(d + 4) = b; }
        }
    }
#endif
#undef IN
#undef SEAM
}

#ifndef N_LAUNCHES
#define N_LAUNCHES 1
#endif
constexpr int NPHASE = 9;
extern "C" void kernel_launch(void* const* d_in, const int* in_sizes, int n_in, void* d_out, int out_size, void* d_ws, size_t ws_size, hipStream_t stream) {
    static int grid = 0;
    if (grid == 0) {
        if (n_in != 17 || ws_size < WS_END) { fprintf(stderr, "kernel_launch: unexpected n_in %d / ws %zu\n", n_in, ws_size); grid = -1; return; }
        int dev = 0, cus = 0, per_cu = 0;
        (void)hipGetDevice(&dev); (void)hipDeviceGetAttribute(&cus, hipDeviceAttributeMultiprocessorCount, dev);
        if (hipFuncSetAttribute((const void*)fwd_kernel, hipFuncAttributeMaxDynamicSharedMemorySize, LDS_BYTES) != hipSuccess) { fprintf(stderr, "kernel_launch: hipFuncSetAttribute failed\n"); grid = -1; return; }
        if (hipOccupancyMaxActiveBlocksPerMultiprocessor(&per_cu, (const void*)fwd_kernel, 512, LDS_BYTES) != hipSuccess || per_cu < 1) { fprintf(stderr, "kernel_launch: occupancy query says %d\n", per_cu); per_cu = 1; }
        (void)hipGetLastError();
        grid = cus;
    }
    if (grid < 0) return;
    (void)hipMemsetAsync((char*)d_ws + WS_CTL, 0, CTL_BYTES, stream);
    Args a{};
    for (int i = 0; i < 17; ++i) a.in[i] = (const float*)d_in[i];
    a.out = (float*)d_out; a.ws = (unsigned char*)d_ws;
#if N_LAUNCHES == 1
#ifndef PH_HI
#define PH_HI NPHASE
#endif
    a.ph_lo = 0; a.ph_hi = PH_HI;
    hipLaunchKernelGGL(fwd_kernel, dim3(grid), dim3(512), LDS_BYTES, stream, a);
#else
    for (int p = 0; p < NPHASE; ++p) { a.ph_lo = p; a.ph_hi = p + 1; hipLaunchKernelGGL(fwd_kernel, dim3(grid), dim3(512), LDS_BYTES, stream, a); }
#endif
}
```
